# Optimizing an MI355X kernel written in HIP

```python
import jax, jax.numpy as jnp
from jax import lax
import numpy as np

D_MODEL = 1024
BATCH = 16
SEQ = 2048
DEPTH = 1

HEAD_DIM = 64
ROPE_DIM = HEAD_DIM // 4
ROPE_THETA = 500000.0
NORM_EPS = 1e-6
ATTN_SCALE = HEAD_DIM ** -0.5

NSA_HEADS = 8
NSA_GROUPS = 2
NSA_REP = NSA_HEADS // NSA_GROUPS
CMP_LEN = 32
CMP_STRIDE = 16
CMP_HIDDEN = 256
SEL_BLOCK = 64
SEL_TOPN = 8
WINDOW = 512
WIN_QBLOCK = 128
NSA_QCHUNK = 64

MOBA_HEADS = 8
MOBA_BLOCK = 256
MOBA_TOPK = 3
MOBA_QCHUNK = 16

PAD_MULT = 256
D_FF = ((-(-8 * D_MODEL // 3)) + 255) // 256 * 256
PLE_DIM = 256

IN_SPLITS = ((NSA_HEADS * HEAD_DIM,) + (NSA_GROUPS * HEAD_DIM,) * 6 + (3 * NSA_HEADS,)
             + (MOBA_HEADS * HEAD_DIM,) * 3 + (D_MODEL, D_MODEL))
IN_COLS = sum(IN_SPLITS)
IN_CUTS = tuple(int(c) for c in np.cumsum(IN_SPLITS)[:-1])

kernel_name = 'hybrid_nsa_moba_swiglu_ple'


def rms_norm(x, g):
    xf = x.astype(jnp.float32)
    y = xf * lax.rsqrt(jnp.mean(xf * xf, axis=-1, keepdims=True) + NORM_EPS)
    return (y * g.astype(jnp.float32)).astype(x.dtype)


def partial_rope(t, pos):
    half = ROPE_DIM // 2
    inv_freq = ROPE_THETA ** (-jnp.arange(half, dtype=jnp.float32) / half)
    ang = pos.astype(jnp.float32)[..., None] * inv_freq
    cos, sin = jnp.cos(ang), jnp.sin(ang)
    tr = t[..., :ROPE_DIM].astype(jnp.float32)
    t1, t2 = tr[..., :half], tr[..., half:]
    rot = jnp.concatenate([t1 * cos - t2 * sin, t2 * cos + t1 * sin], axis=-1)
    return jnp.concatenate([rot.astype(t.dtype), t[..., ROPE_DIM:]], axis=-1)


def masked_softmax(scores, mask):
    s = jnp.where(mask, scores.astype(jnp.float32), -jnp.inf)
    m = jnp.max(s, axis=-1, keepdims=True)
    m = jnp.where(jnp.isfinite(m), m, 0.0)
    e = jnp.where(mask, jnp.exp(s - m), 0.0)
    return e / jnp.maximum(jnp.sum(e, axis=-1, keepdims=True), 1e-30)


def to_heads(t, n):
    b, s, _ = t.shape
    return t.reshape(b, s, n, HEAD_DIM).transpose(0, 2, 1, 3)


def from_heads(t):
    b, n, s, d = t.shape
    return t.transpose(0, 2, 1, 3).reshape(b, s, n * d)


def compress_blocks(t, pe, w1, w2):
    b, g, sp, d = t.shape
    n_sub, per = sp // CMP_STRIDE, CMP_LEN // CMP_STRIDE
    sub = t.reshape(b, g, n_sub, CMP_STRIDE, d)
    nc = n_sub - per + 1
    blocks = jnp.concatenate([sub[:, :, i:i + nc] for i in range(per)], axis=3)
    flat = (blocks + pe).reshape(b, g, nc, CMP_LEN * d)
    return jax.nn.silu(flat @ w1) @ w2


def nsa_mixer(q_in, kc_in, vc_in, ks_in, vs_in, kw_in, vw_in, gate_in, pos_pad,
              q_gain, kc_gain, ks_gain, kw_gain, pe_k, pe_v, ck_w1, ck_w2, cv_w1, cv_w2):
    b, sp, _ = q_in.shape
    G, R, dh = NSA_GROUPS, NSA_REP, HEAD_DIM
    pos_h = pos_pad[:, None, :]
    t_idx = jnp.arange(sp)
    q = partial_rope(rms_norm(to_heads(q_in, NSA_HEADS), q_gain), pos_h).reshape(b, G, R, sp, dh)

    kc = rms_norm(compress_blocks(to_heads(kc_in, G), pe_k, ck_w1, ck_w2), kc_gain)
    vc = compress_blocks(to_heads(vc_in, G), pe_v, cv_w1, cv_w2)
    nc = kc.shape[2]
    cmp_start = jnp.arange(nc) * CMP_STRIDE
    cmp_end = cmp_start + CMP_LEN - 1
    kc = partial_rope(kc, pos_pad[:, cmp_end][:, None, :])
    s_c = jnp.einsum('bgrtd,bgcd->bgrtc', q, kc) * ATTN_SCALE
    p_c = masked_softmax(s_c, cmp_end[None, :] <= t_idx[:, None])
    o_c = jnp.einsum('bgrtc,bgcd->bgrtd', p_c.astype(vc.dtype), vc)

    ns = sp // SEL_BLOCK
    j = jnp.arange(ns)
    overlap = ((cmp_start[:, None] <= j[None, :] * SEL_BLOCK + SEL_BLOCK - 1)
               & (cmp_end[:, None] >= j[None, :] * SEL_BLOCK)).astype(jnp.float32)
    imp = jnp.einsum('bgrtc,cj->bgtj', p_c, overlap)
    cur = (t_idx // SEL_BLOCK)[:, None]
    forced = (j[None, :] == 0) | (j[None, :] == cur) | (j[None, :] == cur - 1)
    imp = jnp.where(forced, jnp.inf, jnp.where(j[None, :] > cur, -jnp.inf, imp))
    n_top = min(SEL_TOPN, ns)
    _, sel_idx = lax.top_k(imp, n_top)

    ks = partial_rope(rms_norm(to_heads(ks_in, G), ks_gain), pos_h)
    vs = to_heads(vs_in, G)
    ks_blk = ks.reshape(b, G, ns, SEL_BLOCK, dh)
    vs_blk = vs.reshape(b, G, ns, SEL_BLOCK, dh)
    nq = sp // NSA_QCHUNK
    bi = jnp.arange(b)[:, None, None, None]
    gi = jnp.arange(G)[None, :, None, None]
    m_sel = n_top * SEL_BLOCK

    def sel_chunk(args):
        qc, ic, tc = args
        kg = ks_blk[bi, gi, ic].reshape(b, G, NSA_QCHUNK, m_sel, dh)
        vg = vs_blk[bi, gi, ic].reshape(b, G, NSA_QCHUNK, m_sel, dh)
        kpos = (ic[..., None] * SEL_BLOCK + jnp.arange(SEL_BLOCK)).reshape(b, G, NSA_QCHUNK, m_sel)
        mask = (kpos <= tc[None, None, :, None])[:, :, None]
        s = jnp.einsum('bgrcd,bgcmd->bgrcm', qc, kg) * ATTN_SCALE
        pr = masked_softmax(s, mask)
        return jnp.einsum('bgrcm,bgcmd->bgrcd', pr.astype(vg.dtype), vg)

    q_ch = q.reshape(b, G, R, nq, NSA_QCHUNK, dh).transpose(3, 0, 1, 2, 4, 5)
    idx_ch = sel_idx.reshape(b, G, nq, NSA_QCHUNK, n_top).transpose(2, 0, 1, 3, 4)
    o_s = lax.map(sel_chunk, (q_ch, idx_ch, t_idx.reshape(nq, NSA_QCHUNK)))
    o_s = o_s.transpose(1, 2, 3, 0, 4, 5).reshape(b, G, R, sp, dh)

    kw = partial_rope(rms_norm(to_heads(kw_in, G), kw_gain), pos_h)
    vw = to_heads(vw_in, G)
    nw, nprev = sp // WIN_QBLOCK, WINDOW // WIN_QBLOCK
    band = (nprev + 1) * WIN_QBLOCK

    def banded(t):
        tb = jnp.pad(t.reshape(b, G, nw, WIN_QBLOCK, dh), ((0, 0), (0, 0), (nprev, 0), (0, 0), (0, 0)))
        return jnp.concatenate([tb[:, :, i:i + nw] for i in range(nprev + 1)], axis=3).transpose(2, 0, 1, 3, 4)

    def win_block(args):
        qb, kb, vb, w = args
        qpos = w * WIN_QBLOCK + jnp.arange(WIN_QBLOCK)
        kpos = (w - nprev) * WIN_QBLOCK + jnp.arange(band)
        diff = qpos[:, None] - kpos[None, :]
        mask = (diff >= 0) & (diff < WINDOW) & (kpos[None, :] >= 0)
        s = jnp.einsum('bgrqd,bgkd->bgrqk', qb, kb) * ATTN_SCALE
        pr = masked_softmax(s, mask)
        return jnp.einsum('bgrqk,bgkd->bgrqd', pr.astype(vb.dtype), vb)

    q_w = q.reshape(b, G, R, nw, WIN_QBLOCK, dh).transpose(3, 0, 1, 2, 4, 5)
    o_w = lax.map(win_block, (q_w, banded(kw), banded(vw), jnp.arange(nw)))
    o_w = o_w.transpose(1, 2, 3, 0, 4, 5).reshape(b, G, R, sp, dh)

    g = jax.nn.sigmoid(gate_in.reshape(b, sp, NSA_HEADS, 3)).transpose(0, 2, 1, 3).reshape(b, G, R, sp, 3)
    o = g[..., 0:1] * o_c + g[..., 1:2] * o_s + g[..., 2:3] * o_w
    return from_heads(o.reshape(b, NSA_HEADS, sp, dh))


def moba_mixer(q_in, k_in, v_in, pos_pad, q_gain, k_gain):
    b, sp, _ = q_in.shape
    H, dh, BS, C = MOBA_HEADS, HEAD_DIM, MOBA_BLOCK, MOBA_QCHUNK
    pos_h = pos_pad[:, None, :]
    t_idx = jnp.arange(sp)
    q = partial_rope(rms_norm(to_heads(q_in, H), q_gain), pos_h)
    k = partial_rope(rms_norm(to_heads(k_in, H), k_gain), pos_h)
    v = to_heads(v_in, H)
    nb = sp // BS
    k_blk = k.reshape(b, H, nb, BS, dh)
    v_blk = v.reshape(b, H, nb, BS, dh)
    k_mean = jnp.mean(k_blk.astype(jnp.float32), axis=3)
    score = jnp.einsum('bhtd,bhnd->bhtn', q.astype(jnp.float32), k_mean)
    own = (t_idx // BS)[:, None]
    score = jnp.where(jnp.arange(nb)[None, :] < own, score, -jnp.inf)
    n_top = min(MOBA_TOPK, nb)
    _, sel_idx = lax.top_k(score, n_top)
    bi = jnp.arange(b)[:, None, None, None]
    hi = jnp.arange(H)[None, :, None, None]
    nq = sp // C
    m_sel = n_top * BS

    def chunk(args):
        qc, ic, c = args
        start = c * C
        blk = start // BS
        k_own = lax.dynamic_slice_in_dim(k, blk * BS, BS, axis=2)
        v_own = lax.dynamic_slice_in_dim(v, blk * BS, BS, axis=2)
        qpos = start + jnp.arange(C)
        m_own = jnp.broadcast_to(blk * BS + jnp.arange(BS)[None, :] <= qpos[:, None], (b, H, C, BS))
        m_sel_mask = jnp.broadcast_to((ic < blk)[..., None], (b, H, C, n_top, BS)).reshape(b, H, C, m_sel)
        kg = k_blk[bi, hi, ic].reshape(b, H, C, m_sel, dh)
        vg = v_blk[bi, hi, ic].reshape(b, H, C, m_sel, dh)
        s = jnp.concatenate([jnp.einsum('bhcd,bhpd->bhcp', qc, k_own),
                             jnp.einsum('bhcd,bhcmd->bhcm', qc, kg)], axis=-1) * ATTN_SCALE
        pr = masked_softmax(s, jnp.concatenate([m_own, m_sel_mask], axis=-1)).astype(v.dtype)
        return (jnp.einsum('bhcp,bhpd->bhcd', pr[..., :BS], v_own)
                + jnp.einsum('bhcm,bhcmd->bhcd', pr[..., BS:], vg))

    q_ch = q.reshape(b, H, nq, C, dh).transpose(2, 0, 1, 3, 4)
    idx_ch = sel_idx.reshape(b, H, nq, C, n_top).transpose(2, 0, 1, 3, 4)
    o = lax.map(chunk, (q_ch, idx_ch, jnp.arange(nq)))
    o = o.transpose(1, 2, 0, 3, 4).reshape(b, H, sp, dh)
    return from_heads(o)


def setup_inputs(seed: int = 0) -> dict:
    key = jax.random.key(seed)
    ks = jax.random.split(key, 25)

    def normal(k, shape, scale):
        return jax.random.normal(k, shape, jnp.float32) * scale

    def gain(k, n):
        return 1.0 + 0.1 * jax.random.normal(k, (DEPTH, n), jnp.float32)

    L, dh = DEPTH, HEAD_DIM
    nsa_w, moba_w = NSA_HEADS * dh, MOBA_HEADS * dh
    return {
        'x': normal(ks[0], (BATCH, SEQ, D_MODEL), 1.0),
        'p': normal(ks[1], (DEPTH, BATCH, SEQ, PLE_DIM), 1.0),
        'positions': jnp.tile(jnp.arange(SEQ, dtype=jnp.int32)[None, :], (BATCH, 1)),
        'g_mix': gain(ks[2], D_MODEL),
        'w_in': normal(ks[3], (L, D_MODEL, IN_COLS), D_MODEL ** -0.5),
        'nsa_q_gain': gain(ks[4], dh),
        'nsa_kc_gain': gain(ks[5], dh),
        'nsa_ks_gain': gain(ks[6], dh),
        'nsa_kw_gain': gain(ks[7], dh),
        'nsa_pe_k': normal(ks[8], (L, CMP_LEN, dh), 0.1),
        'nsa_pe_v': normal(ks[9], (L, CMP_LEN, dh), 0.1),
        'nsa_ck_w1': normal(ks[10], (L, CMP_LEN * dh, CMP_HIDDEN), (CMP_LEN * dh) ** -0.5),
        'nsa_ck_w2': normal(ks[11], (L, CMP_HIDDEN, dh), CMP_HIDDEN ** -0.5),
        'nsa_cv_w1': normal(ks[12], (L, CMP_LEN * dh, CMP_HIDDEN), (CMP_LEN * dh) ** -0.5),
        'nsa_cv_w2': normal(ks[13], (L, CMP_HIDDEN, dh), CMP_HIDDEN ** -0.5),
        'moba_q_gain': gain(ks[14], dh),
        'moba_k_gain': gain(ks[15], dh),
        'w_up_nsa': normal(ks[16], (L, nsa_w, D_MODEL), nsa_w ** -0.5),
        'w_up_moba': normal(ks[17], (L, moba_w, D_MODEL), moba_w ** -0.5),
        'w_out': normal(ks[18], (L, D_MODEL, D_MODEL), D_MODEL ** -0.5),
        'g_ffn': gain(ks[19], D_MODEL),
        'w_ffn_in': normal(ks[20], (L, D_MODEL, 2 * D_FF), D_MODEL ** -0.5),
        'w_ffn_out': normal(ks[21], (L, D_FF, D_MODEL), D_FF ** -0.5),
        'g_ple': gain(ks[22], D_MODEL),
        'w_ple_gate': normal(ks[23], (L, D_MODEL, D_MODEL), D_MODEL ** -0.5),
        'w_ple_proj': normal(ks[24], (L, PLE_DIM, D_MODEL), PLE_DIM ** -0.5),
    }


def reference(x, p, positions, g_mix, w_in, nsa_q_gain, nsa_kc_gain, nsa_ks_gain, nsa_kw_gain,
              nsa_pe_k, nsa_pe_v, nsa_ck_w1, nsa_ck_w2, nsa_cv_w1, nsa_cv_w2,
              moba_q_gain, moba_k_gain, w_up_nsa, w_up_moba, w_out,
              g_ffn, w_ffn_in, w_ffn_out, g_ple, w_ple_gate, w_ple_proj):
    b, s, _ = x.shape
    sp = -(-s // PAD_MULT) * PAD_MULT
    extra = jnp.arange(1, sp - s + 1, dtype=positions.dtype)
    pos_pad = jnp.concatenate([positions, positions[:, -1:] + extra[None, :]], axis=1)
    for i in range(DEPTH):
        proj = rms_norm(x, g_mix[i]) @ w_in[i]
        proj = jnp.pad(proj, ((0, 0), (0, sp - s), (0, 0)))
        (q_n, kc_n, vc_n, ks_n, vs_n, kw_n, vw_n, gate_n,
         q_m, k_m, v_m, gate_a, gate_b) = jnp.split(proj, IN_CUTS, axis=-1)
        y_nsa = nsa_mixer(q_n, kc_n, vc_n, ks_n, vs_n, kw_n, vw_n, gate_n, pos_pad,
                          nsa_q_gain[i], nsa_kc_gain[i], nsa_ks_gain[i], nsa_kw_gain[i],
                          nsa_pe_k[i], nsa_pe_v[i], nsa_ck_w1[i], nsa_ck_w2[i],
                          nsa_cv_w1[i], nsa_cv_w2[i])[:, :s]
        y_moba = moba_mixer(q_m, k_m, v_m, pos_pad, moba_q_gain[i], moba_k_gain[i])[:, :s]
        merged = (jax.nn.sigmoid(gate_a[:, :s]) * (y_nsa @ w_up_nsa[i])
                  + jax.nn.sigmoid(gate_b[:, :s]) * (y_moba @ w_up_moba[i]))
        x = x + merged @ w_out[i]
        gate, up = jnp.split(rms_norm(x, g_ffn[i]) @ w_ffn_in[i], 2, axis=-1)
        x = x + (jax.nn.silu(gate) * up) @ w_ffn_out[i]
        ple_gate = jax.nn.sigmoid(rms_norm(x, g_ple[i]) @ w_ple_gate[i])
        x = x + ple_gate * (p[i] @ w_ple_proj[i])
    return x
```

```cpp
#include <hip/hip_runtime.h>
#include <hip/hip_cooperative_groups.h>
#include <cstdio>
#include <cstdint>
#include <cmath>
namespace cg = cooperative_groups;

#ifndef MK_PER_PHASE
#define MK_PER_PHASE 0
#endif

#ifndef REPEAT_PHASE
#define REPEAT_PHASE 0
#endif
#define NREP(k) ((((REPEAT_PHASE) >> (k)) & 1) ? 2 : 1)
#define LAS __attribute__((address_space(3)))
typedef unsigned short bf16_t;
typedef short bf16x8 __attribute__((ext_vector_type(8)));
typedef short s16x4 __attribute__((ext_vector_type(4)));
typedef float f32x4 __attribute__((ext_vector_type(4)));
typedef float f32x16 __attribute__((ext_vector_type(16)));
typedef unsigned u32x4 __attribute__((ext_vector_type(4)));
typedef unsigned u32x2 __attribute__((ext_vector_type(2)));
typedef float f32x2_t __attribute__((ext_vector_type(2)));
typedef __bf16 bf16x2_t __attribute__((ext_vector_type(2)));

__device__ __forceinline__ unsigned cvtpk(float lo, float hi) { f32x2_t v = {lo, hi}; bf16x2_t b = __builtin_convertvector(v, bf16x2_t); return __builtin_bit_cast(unsigned, b); }
__device__ __forceinline__ float swap32(float v) { auto rr = __builtin_amdgcn_permlane32_swap(__builtin_bit_cast(unsigned, v), __builtin_bit_cast(unsigned, v), false, false); return __builtin_bit_cast(float, (threadIdx.x & 32) ? rr[0] : rr[1]); }
__device__ __forceinline__ float bf2f(unsigned short b) { return __builtin_bit_cast(float, (unsigned)b << 16); }
__device__ __forceinline__ float sigmoidf_(float x) { return __builtin_amdgcn_rcpf(1.0f + __builtin_amdgcn_exp2f(-1.4426950408889634f * x)); }

constexpr int DM = 1024, NB = 16, SEQ = 2048, T = NB * SEQ;
constexpr int HD = 64, NSA_H = 8, NSA_G = 2, MOBA_H = 8;
constexpr int NCMP = 127, NCMP_PAD = 128;
constexpr int DFF = 2816, PLE = 256, IN_COLS = 4888, IN_PAD = 5120;
constexpr float EPS = 1e-6f;
constexpr float C2 = 0.125f * 1.4426950408889634f;

constexpr size_t MiB = 1u << 20;
constexpr size_t WS_CTL = 0;
constexpr size_t WS_WIN = 1 * MiB, WS_WFFI = 11 * MiB, WS_WFFO = 22 * MiB, WS_WOUT = 28 * MiB, WS_WPG = 30 * MiB, WS_WUPN = 32 * MiB, WS_WUPM = 33 * MiB,
                 WS_WPP = 34 * MiB, WS_WCK1 = 35 * MiB, WS_WCV1 = 36 * MiB, WS_WCK2 = 37 * MiB, WS_WCV2 = 37 * MiB + 256 * 1024;
constexpr size_t WS_RSTD0 = 38 * MiB, WS_PBIAS = 38 * MiB + 256 * 1024, WS_B1 = 38 * MiB + 512 * 1024, WS_KMEAN = 39 * MiB, WS_KCC = 40 * MiB, WS_VCC = 41 * MiB,
                 WS_HID = 42 * MiB, WS_ROPE = 46 * MiB, WS_RSSP = 48 * MiB, WS_GN = 50 * MiB, WS_PB = 54 * MiB;
constexpr size_t WS_XB = 72 * MiB;
constexpr size_t WS_YN = 72 * MiB, WS_YM = 104 * MiB;
constexpr size_t WS_QN = 136 * MiB, WS_QM = 168 * MiB, WS_KM = 200 * MiB, WS_VM = 232 * MiB,
                 WS_KC = 264 * MiB, WS_VC = 272 * MiB, WS_KS = 280 * MiB, WS_VS = 288 * MiB, WS_KW = 296 * MiB, WS_VW = 304 * MiB;
constexpr size_t WS_MB = 136 * MiB, WS_HB = 136 * MiB;
constexpr size_t WS_GA = 312 * MiB, WS_GB = 376 * MiB, WS_PP = 440 * MiB, WS_END = 504 * MiB;

namespace pg8 {
constexpr int BM = 256, BK = 64, HALF = 128, HTB = HALF * BK * 2, STAGE_BYTES = 8 * HTB, NXCD = 8, WGM = 8;
__host__ __device__ __forceinline__ int lds_byte(int r, int c) { const int st = (r >> 4) * 2 + (c >> 5), rr = r & 15, cc = c & 31, ob = rr * 64 + cc * 2; return st * 1024 + (ob ^ (((ob >> 9) & 1) << 5)); }
__host__ __device__ __forceinline__ void stage_rc(int b, int& R, int& C) { const int st = b / 1024, sb = b % 1024, swz = sb ^ (((sb >> 9) & 1) << 5); R = (st >> 1) * 16 + swz / 64; C = (st & 1) * 32 + (swz % 64) / 2; }

struct Unit { int pm, pn, aux; const char* A; const char* B; };
struct StaticOrder {
    int nM, nN, nwg, G, c;
    __host__ __device__ void init(int M, int N, int G_, int c_) { nM = M / BM; nN = N / BM; nwg = nM * nN; G = G_; c = c_; }
    __host__ __device__ bool next(int i, int& pm, int& pn) const {
        const long L = (long)i * G + c; if (L >= nwg) return false;
        int wgid = (int)L; { const int q = nwg / NXCD, r = nwg % NXCD, xcd = wgid % NXCD, off = wgid / NXCD; wgid = (xcd < r ? xcd * (q + 1) : r * (q + 1) + (xcd - r) * q) + off; }
        const int nig = WGM * nN, gid = wgid / nig, fm = gid * WGM, gsz = (nM - fm) < WGM ? (nM - fm) : WGM;
        pm = fm + ((wgid % nig) % gsz); pn = (wgid % nig) / gsz; return true;
    }
};

template <class Epi, class Sched>
__device__ __forceinline__ void gemm_phase(LAS unsigned char* lds, const int K_in, const int lda, const int ldb, const Sched& S, const Epi& E) {
    int K = K_in; asm volatile("" : "+s"(K));
    const int tid = threadIdx.x, wid = __builtin_amdgcn_readfirstlane(tid >> 6), lane = tid & 63, wr = wid >> 2, wc = wid & 3, fr = lane & 15, fq = lane >> 4;
    const int nt = K / BK;
    unsigned voffA[2], voffB[2];
#pragma unroll
    for (int i = 0; i < 2; ++i) { int R, C; stage_rc(tid * 16 + i * 8192, R, C); voffA[i] = (unsigned)(R * lda + C) * 2u; voffB[i] = (unsigned)(R * ldb + C) * 2u; }
    const size_t kstep = (size_t)(BK * 2);
    const size_t hstepA = (size_t)HALF * lda * 2, hstepB = (size_t)HALF * ldb * 2;
    const unsigned ldsw = (unsigned)wid * 1024u;
    const int aoff = lds_byte(wr * 64 + fr, fq * 8), boff = lds_byte(wc * 32 + fr, fq * 8);
#define PG8_SA(b, h) (((b) * 2 + (h)) * HTB)
#define PG8_SB(b, h) ((4 + (b) * 2 + (h)) * HTB)
#define PG8_STAGE(bufoff, gbase, voff) do { _Pragma("unroll") for (int _i = 0; _i < 2; ++_i) \
        __builtin_amdgcn_global_load_lds((const unsigned*)((const char*)(gbase) + (voff)[_i]), (LAS unsigned*)(lds + (bufoff) + ldsw + _i * 8192), 16, 0, 0); } while (0)
#define PG8_LDA(dst, b, h) do { _Pragma("unroll") for (int m = 0; m < 4; ++m) _Pragma("unroll") for (int k = 0; k < 2; ++k) dst[m][k] = *(const LAS bf16x8*)(lds + PG8_SA(b, h) + aoff + m * 2048 + k * 1024); } while (0)
#define PG8_LDB(dst, b, h) do { _Pragma("unroll") for (int n = 0; n < 2; ++n) _Pragma("unroll") for (int k = 0; k < 2; ++k) dst[n][k] = *(const LAS bf16x8*)(lds + PG8_SB(b, h) + boff + n * 2048 + k * 1024); } while (0)
#define PG8_MMA(ai, bj, At, Bt) do { __builtin_amdgcn_s_setprio(1); _Pragma("unroll") for (int m = 0; m < 4; ++m) _Pragma("unroll") for (int n = 0; n < 2; ++n) _Pragma("unroll") for (int k = 0; k < 2; ++k) \
        acc[ai][bj][m][n] = __builtin_amdgcn_mfma_f32_16x16x32_bf16(Bt[n][k], At[m][k], acc[ai][bj][m][n], 0, 0, 0); __builtin_amdgcn_s_setprio(0); } while (0)
#define PG8_WAIT_V(n) asm volatile("s_waitcnt vmcnt(" #n ")" ::: "memory")
#define PG8_WAIT_L(n) asm volatile("s_waitcnt lgkmcnt(" #n ")" ::: "memory")
#define PG8_BAR __builtin_amdgcn_s_barrier()
#define PG8_SCHED __builtin_amdgcn_sched_barrier(0)
    Unit cur, nxt; int ui = 0;
    if (!S.next(0, cur)) return;
    f32x4 acc[2][2][4][2];
#pragma unroll
    for (int a = 0; a < 2; ++a)
#pragma unroll
        for (int b = 0; b < 2; ++b)
#pragma unroll
            for (int m = 0; m < 4; ++m)
#pragma unroll
                for (int n = 0; n < 2; ++n) acc[a][b][m][n] = (f32x4){0.f, 0.f, 0.f, 0.f};
    bf16x8 At[4][2], B0[2][2], B1[2][2];
    const char* cA = cur.A; const char* cB = cur.B;
    PG8_STAGE(PG8_SB(0, 0), cB, voffB); PG8_STAGE(PG8_SB(0, 1), cB + hstepB, voffB); PG8_STAGE(PG8_SA(0, 0), cA, voffA); PG8_STAGE(PG8_SA(0, 1), cA + hstepA, voffA);
    if (wr == 1) PG8_BAR;
    PG8_WAIT_V(2); PG8_BAR;
    PG8_STAGE(PG8_SB(1, 0), cB + kstep, voffB); PG8_STAGE(PG8_SA(1, 0), cA + kstep, voffA); PG8_STAGE(PG8_SB(1, 1), cB + hstepB + kstep, voffB);
    PG8_WAIT_V(6); PG8_BAR;
    for (;;) {
        const bool has_next = S.next(ui + 1, nxt);
        const char* nA = has_next ? nxt.A : cA; const char* nB = has_next ? nxt.B : cB;
        for (int t = 0; t < nt; t += 2) {
            const bool last = (t == nt - 2);
            const char* a1 = cA + (size_t)(t + 1) * kstep;
            const char* a2 = last ? nA : cA + (size_t)(t + 2) * kstep; const char* b2 = last ? nB : cB + (size_t)(t + 2) * kstep;
            const char* a3 = a2 + kstep; const char* b3 = b2 + kstep;
            PG8_LDB(B0, 0, 0); PG8_LDB(B1, 0, 1); PG8_SCHED; PG8_LDA(At, 0, 0); PG8_STAGE(PG8_SA(1, 1), a1 + hstepA, voffA);
            PG8_WAIT_V(8); PG8_WAIT_L(0); PG8_BAR; PG8_MMA(0, 0, At, B0); PG8_MMA(0, 1, At, B1); PG8_BAR; PG8_SCHED;
            PG8_LDA(At, 0, 1); PG8_STAGE(PG8_SB(0, 0), b2, voffB); PG8_STAGE(PG8_SB(0, 1), b2 + hstepB, voffB); PG8_STAGE(PG8_SA(0, 0), a2, voffA);
            PG8_WAIT_V(8); PG8_WAIT_L(0); PG8_BAR; PG8_MMA(1, 0, At, B0); PG8_MMA(1, 1, At, B1); PG8_BAR; PG8_SCHED;
            PG8_LDB(B0, 1, 0); PG8_LDB(B1, 1, 1); PG8_SCHED; PG8_LDA(At, 1, 0); PG8_STAGE(PG8_SA(0, 1), a2 + hstepA, voffA);
            PG8_WAIT_V(8); PG8_WAIT_L(0); PG8_BAR; PG8_MMA(0, 0, At, B0); PG8_MMA(0, 1, At, B1); PG8_BAR; PG8_SCHED;
            PG8_LDA(At, 1, 1); PG8_STAGE(PG8_SB(1, 0), b3, voffB); PG8_STAGE(PG8_SB(1, 1), b3 + hstepB, voffB); PG8_STAGE(PG8_SA(1, 0), a3, voffA);
            PG8_WAIT_V(8); PG8_WAIT_L(0); PG8_BAR; PG8_MMA(1, 0, At, B0); PG8_MMA(1, 1, At, B1); PG8_BAR; PG8_SCHED;
        }
        if (wr == 0) PG8_BAR;
        E(acc, cur, wr, wc, fr, fq);
        if (!has_next) break;
#pragma unroll
        for (int a = 0; a < 2; ++a)
#pragma unroll
            for (int b = 0; b < 2; ++b)
#pragma unroll
                for (int m = 0; m < 4; ++m)
#pragma unroll
                    for (int n = 0; n < 2; ++n) acc[a][b][m][n] = (f32x4){0.f, 0.f, 0.f, 0.f};
        cur = nxt; cA = nA; cB = nB; ++ui;
        if (wr == 1) PG8_BAR;
    }
    PG8_WAIT_V(0);
    PG8_BAR;
#undef PG8_SA
#undef PG8_SB
#undef PG8_STAGE
#undef PG8_LDA
#undef PG8_LDB
#undef PG8_MMA
#undef PG8_WAIT_V
#undef PG8_WAIT_L
#undef PG8_BAR
#undef PG8_SCHED
}
}
using pg8::Unit;
typedef f32x4 Acc[2][2][4][2];

__host__ __device__ __forceinline__ int phys_col(int L) { const int tile = L >> 8, l = L & 255, wc = l >> 6, fq = (l >> 4) & 3, bj = (l >> 3) & 1, n = (l >> 2) & 1, i = l & 3; return tile * 256 + 128 * bj + 32 * wc + 16 * n + 4 * fq + i; }

struct SchedStd {
    pg8::StaticOrder so; const char* A; const char* B; size_t a_tile, b_tile; int nmine, reps;
    __device__ __forceinline__ void init(const void* A_, int lda, const void* B_, int ldb, int M, int N, int reps_ = 1) { so.init(M, N, (int)gridDim.x, (int)blockIdx.x); A = (const char*)A_; B = (const char*)B_; a_tile = (size_t)256 * lda * 2; b_tile = (size_t)256 * ldb * 2;
        nmine = so.nwg > so.c ? (so.nwg - so.c + so.G - 1) / so.G : 0; reps = reps_; }
    __device__ __forceinline__ bool next(int i, Unit& u) const { int pm, pn; if (i >= nmine * reps) return false; so.next(i % nmine, pm, pn); u.pm = pm; u.pn = pn; u.aux = 0; u.A = A + (size_t)pm * a_tile; u.B = B + (size_t)pn * b_tile; return true; }
};
struct SchedMerge {
    pg8::StaticOrder so; const char* A0; const char* A1; const char* B0; const char* B1; size_t a_tile, b_tile; int nmine;
    __device__ __forceinline__ void init(const void* A0_, const void* A1_, const void* B0_, const void* B1_, int ld, int M, int N) { so.init(M, N, (int)gridDim.x, (int)blockIdx.x);
        A0 = (const char*)A0_; A1 = (const char*)A1_; B0 = (const char*)B0_; B1 = (const char*)B1_; a_tile = (size_t)256 * ld * 2; b_tile = (size_t)256 * ld * 2;
        nmine = so.nwg > so.c ? (so.nwg - so.c + so.G - 1) / so.G : 0; }
    __device__ __forceinline__ bool next(int i, Unit& u) const { int pm, pn; if (i >= 2 * nmine) return false; so.next(i >> 1, pm, pn); u.pm = pm; u.pn = pn; u.aux = i & 1;
        u.A = ((i & 1) ? A1 : A0) + (size_t)pm * a_tile; u.B = ((i & 1) ? B1 : B0) + (size_t)pn * b_tile; return true; }
};
struct SchedCmp {
    const char* A0; const char* A1; const char* B0; const char* B1; size_t a_tile;
    __device__ __forceinline__ bool next(int i, Unit& u) const { const int c = (int)blockIdx.x; if (i >= NREP(2) || c >= 32) return false; u.aux = c >> 4; u.pm = c & 15; u.pn = 0; u.A = (u.aux ? A1 : A0) + (size_t)u.pm * a_tile; u.B = u.aux ? B1 : B0; return true; }
};

#define EPI_ROWS_BEGIN _Pragma("unroll") for (int ai = 0; ai < 2; ++ai) _Pragma("unroll") for (int m = 0; m < 4; ++m) { const int row = u.pm * 256 + ai * 128 + wr * 64 + m * 16 + fr; float v[16]; \
    _Pragma("unroll") for (int bj = 0; bj < 2; ++bj) _Pragma("unroll") for (int n = 0; n < 2; ++n) _Pragma("unroll") for (int i = 0; i < 4; ++i) v[8 * bj + 4 * n + i] = acc[ai][bj][m][n][i];
#define EPI_ROWS_END }
__device__ __forceinline__ void store_bf16x16(bf16_t* dst, const float (&v)[16]) {
    u32x4 a, b; a.x = cvtpk(v[0], v[1]); a.y = cvtpk(v[2], v[3]); a.z = cvtpk(v[4], v[5]); a.w = cvtpk(v[6], v[7]);
    b.x = cvtpk(v[8], v[9]); b.y = cvtpk(v[10], v[11]); b.z = cvtpk(v[12], v[13]); b.w = cvtpk(v[14], v[15]);
    *(u32x4*)dst = a; *(u32x4*)(dst + 8) = b;
}
__device__ __forceinline__ float rstd_from_parts(const float* rssp, int row) {
    const f32x4* p = (const f32x4*)(rssp + (size_t)row * 16); const f32x4 a = p[0], b = p[1], c = p[2], d = p[3];
    const float s = ((a.x + a.y) + (a.z + a.w)) + ((b.x + b.y) + (b.z + b.w)) + ((c.x + c.y) + (c.z + c.w)) + ((d.x + d.y) + (d.z + d.w));
    return rsqrtf(s * (1.0f / DM) + EPS);
}

struct EpiProj {
    const float* rstd0; const float* rope; const float* gq; const float* gks; const float* gkw; const float* gmq; const float* gmk;
    bf16_t *QN, *KC, *VC, *KS, *VS, *KW, *VW, *QM, *KM, *VM, *GA, *GB; float* GN;
    __device__ __forceinline__ void operator()(const Acc& acc, const Unit& u, int wr, int wc, int fr, int fq) const {
        const int slot = u.pn * 4 + wc;
        int kind; bf16_t* base; const float* gain = nullptr; int nh = 1, hh = 0; bool ropeq = false; float sc = 1.f;
        if (slot < 8) { kind = 0; base = QN; gain = gq; nh = 8; hh = slot; ropeq = true; sc = C2; }
        else if (slot < 20) { const int s2 = slot - 8, which = s2 >> 1; kind = 0; nh = 2; hh = s2 & 1;
            base = which == 0 ? KC : which == 1 ? VC : which == 2 ? KS : which == 3 ? VS : which == 4 ? KW : VW;
            if (which == 2) { gain = gks; ropeq = true; } else if (which == 4) { gain = gkw; ropeq = true; } }
        else if (slot < 28) { kind = 0; base = QM; gain = gmq; nh = 8; hh = slot - 20; ropeq = true; sc = C2; }
        else if (slot < 36) { kind = 0; base = KM; gain = gmk; nh = 8; hh = slot - 28; ropeq = true; }
        else if (slot < 44) { kind = 0; base = VM; nh = 8; hh = slot - 36; }
        else if (slot < 60) { kind = 1; base = (bf16_t*)((unsigned char*)GA + (slot - 44) * 64); }
        else if (slot < 76) { kind = 1; base = (bf16_t*)((unsigned char*)GB + (slot - 60) * 64); }
        else if (slot == 76) { kind = 2; base = nullptr; }
        else return;
        float g16[16];
        if (gain) {
#pragma unroll
            for (int c = 0; c < 16; ++c) g16[c] = gain[16 * fq + c] * sc;
        }
        EPI_ROWS_BEGIN
            const float rs = rstd0[row];
            if (kind == 0) {
                if (gain) {
                    float ss = 0.f;
#pragma unroll
                    for (int c = 0; c < 16; ++c) ss += v[c] * v[c];
                    ss += __shfl_xor(ss, 16); ss += __shfl_xor(ss, 32);
                    const float f = rs * rsqrtf(rs * rs * ss * (1.0f / 64.0f) + EPS);
#pragma unroll
                    for (int c = 0; c < 16; ++c) v[c] = v[c] * f * g16[c];
                } else {
#pragma unroll
                    for (int c = 0; c < 16; ++c) v[c] *= rs;
                }
                if (ropeq && fq == 0) {
                    const f32x4* rp = (const f32x4*)(rope + (size_t)row * 16); const f32x4 c0 = rp[0], c1 = rp[1], s0 = rp[2], s1 = rp[3];
                    const float cs[8] = {c0.x, c0.y, c0.z, c0.w, c1.x, c1.y, c1.z, c1.w}, sn[8] = {s0.x, s0.y, s0.z, s0.w, s1.x, s1.y, s1.z, s1.w};
#pragma unroll
                    for (int j = 0; j < 8; ++j) { const float a = v[j], b = v[j + 8]; v[j] = a * cs[j] - b * sn[j]; v[j + 8] = b * cs[j] + a * sn[j]; }
                }
                const int b = row >> 11, t = row & (SEQ - 1);
                store_bf16x16(base + ((size_t)(b * nh + hh) * SEQ + t) * 64 + 16 * fq, v);
            } else if (kind == 1) {
                const float kexp = -1.4426950408889634f * rs;
                unsigned w[4];
#pragma unroll
                for (int c4 = 0; c4 < 4; ++c4) { unsigned pk = 0u;
#pragma unroll
                    for (int i = 0; i < 4; ++i) { const float e = __builtin_amdgcn_exp2f(v[4 * c4 + i] * kexp);
                        pk = __builtin_amdgcn_cvt_pk_u8_f32(__builtin_amdgcn_rcpf(__builtin_fmaf(e, 1.0f / 255.0f, 1.0f / 255.0f)), i, pk); }
                    w[c4] = pk; }
                __builtin_nontemporal_store((u32x4){w[0], w[1], w[2], w[3]}, (u32x4*)((unsigned char*)base + (size_t)row * DM + 16 * fq));
            } else {
                if (fq < 2) {
#pragma unroll
                    for (int c = 0; c < 16; ++c) v[c] = sigmoidf_(v[c] * rs);
                    f32x4* d = (f32x4*)(GN + (size_t)row * 32 + 16 * fq);
                    d[0] = (f32x4){v[0], v[1], v[2], v[3]}; d[1] = (f32x4){v[4], v[5], v[6], v[7]};
                    if (fq == 0) { d[2] = (f32x4){v[8], v[9], v[10], v[11]}; d[3] = (f32x4){v[12], v[13], v[14], v[15]}; }
                }
            }
        EPI_ROWS_END
    }
};
struct EpiCmp1 {
    const float* b1; bf16_t* hid;
    __device__ __forceinline__ void operator()(const Acc& acc, const Unit& u, int wr, int wc, int fr, int fq) const {
        float bb[16];
#pragma unroll
        for (int c = 0; c < 16; ++c) bb[c] = b1[u.aux * 256 + 64 * wc + 16 * fq + c];
        bf16_t* H = hid + (size_t)u.aux * 4096 * 256;
        EPI_ROWS_BEGIN
#pragma unroll
            for (int c = 0; c < 16; ++c) { const float x = v[c] + bb[c]; v[c] = x * sigmoidf_(x); }
            store_bf16x16(H + (size_t)row * 256 + 64 * wc + 16 * fq, v);
        EPI_ROWS_END
    }
};
struct EpiCmp2 {
    const float* gkc; const float* rope; bf16_t* KCC; bf16_t* VCC;
    __device__ __forceinline__ void operator()(const Acc& acc, const Unit& u, int wr, int wc, int fr, int fq) const {
        if (wc != 0) return;
        float g16[16];
#pragma unroll
        for (int c = 0; c < 16; ++c) g16[c] = gkc[16 * fq + c];
        EPI_ROWS_BEGIN
            const int bg = row >> 7, c_ = row & 127, b = bg >> 1;
            if (u.aux == 0) {
                float ss = 0.f;
#pragma unroll
                for (int c = 0; c < 16; ++c) ss += v[c] * v[c];
                ss += __shfl_xor(ss, 16); ss += __shfl_xor(ss, 32);
                const float rn = rsqrtf(ss * (1.0f / 64.0f) + EPS);
#pragma unroll
                for (int c = 0; c < 16; ++c) v[c] = v[c] * rn * g16[c];
                if (fq == 0) {
                    int tp = c_ * 16 + 31; if (tp > SEQ - 1) tp = SEQ - 1;
                    const f32x4* rp = (const f32x4*)(rope + ((size_t)b * SEQ + tp) * 16); const f32x4 c0 = rp[0], c1 = rp[1], s0 = rp[2], s1 = rp[3];
                    const float cs[8] = {c0.x, c0.y, c0.z, c0.w, c1.x, c1.y, c1.z, c1.w}, sn[8] = {s0.x, s0.y, s0.z, s0.w, s1.x, s1.y, s1.z, s1.w};
#pragma unroll
                    for (int j = 0; j < 8; ++j) { const float a = v[j], bq = v[j + 8]; v[j] = a * cs[j] - bq * sn[j]; v[j + 8] = bq * cs[j] + a * sn[j]; }
                }
                store_bf16x16(KCC + (size_t)row * 64 + 16 * fq, v);
            } else {
                store_bf16x16(VCC + (size_t)row * 64 + 16 * fq, v);
            }
        EPI_ROWS_END
    }
};
struct EpiMerge {
    const bf16_t* GA; const bf16_t* GB; bf16_t* MB;
    __device__ __forceinline__ void operator()(const Acc& acc, const Unit& u, int wr, int wc, int fr, int fq) const {
        const int col = u.pn * 256 + 64 * wc + 16 * fq;
        const unsigned char* G = (const unsigned char*)(u.aux ? GB : GA);
        EPI_ROWS_BEGIN
            const u32x4 g0 = *(const u32x4*)(G + (size_t)row * DM + col);
            const unsigned gw[4] = {g0.x, g0.y, g0.z, g0.w};
#pragma unroll
            for (int c = 0; c < 16; ++c) v[c] *= (float)((gw[c >> 2] >> (8 * (c & 3))) & 255u) * (1.0f / 255.0f);
            bf16_t* mp = MB + (size_t)row * DM + col;
            if (u.aux) {
                const u32x4 m0 = ((const u32x4*)mp)[0], m1 = ((const u32x4*)mp)[1];
                const unsigned mw[8] = {m0.x, m0.y, m0.z, m0.w, m1.x, m1.y, m1.z, m1.w};
#pragma unroll
                for (int c = 0; c < 8; ++c) { v[2 * c] += __builtin_bit_cast(float, mw[c] << 16); v[2 * c + 1] += __builtin_bit_cast(float, mw[c] & 0xffff0000u); }
            }
            store_bf16x16(mp, v);
        EPI_ROWS_END
    }
};
template <bool XF32> struct EpiResid {
    const float* xi; bf16_t* xb; float* rssp;
    __device__ __forceinline__ void operator()(const Acc& acc, const Unit& u, int wr, int wc, int fr, int fq) const {
        const int col = u.pn * 256 + 64 * wc + 16 * fq;
        EPI_ROWS_BEGIN
            bf16_t* bp = xb + (size_t)row * DM + col;
            if (XF32) { const f32x4* ip = (const f32x4*)(xi + (size_t)row * DM + col);
#pragma unroll
                for (int q = 0; q < 4; ++q) { const f32x4 x = ip[q]; v[4 * q] += x.x; v[4 * q + 1] += x.y; v[4 * q + 2] += x.z; v[4 * q + 3] += x.w; } }
            else { const u32x4 m0 = ((const u32x4*)bp)[0], m1 = ((const u32x4*)bp)[1]; const unsigned mw[8] = {m0.x, m0.y, m0.z, m0.w, m1.x, m1.y, m1.z, m1.w};
#pragma unroll
                for (int c = 0; c < 8; ++c) { v[2 * c] += __builtin_bit_cast(float, mw[c] << 16); v[2 * c + 1] += __builtin_bit_cast(float, mw[c] & 0xffff0000u); } }
            float ss = 0.f;
#pragma unroll
            for (int c = 0; c < 16; ++c) ss += v[c] * v[c];
            store_bf16x16(bp, v);
            ss += __shfl_xor(ss, 16); ss += __shfl_xor(ss, 32);
            if (fq == 0) rssp[(size_t)row * 16 + u.pn * 4 + wc] = ss;
        EPI_ROWS_END
    }
};
struct EpiFfnIn {
    const float* rssp; bf16_t* HB;
    __device__ __forceinline__ void operator()(const Acc& acc, const Unit& u, int wr, int wc, int fr, int fq) const {
        const int hcol = u.pn * 128 + 32 * wc + 8 * fq;
        EPI_ROWS_BEGIN
            const float rs = rstd_from_parts(rssp, row);
            float h[8];
            const float kexp = -1.4426950408889634f * rs, irs2 = __builtin_amdgcn_rcpf(rs * rs);
#pragma unroll
            for (int c = 0; c < 8; ++c) { const float e = __builtin_amdgcn_exp2f(v[c] * kexp); h[c] = (v[c] * v[c + 8]) * __builtin_amdgcn_rcpf(__builtin_fmaf(e, irs2, irs2)); }
            u32x4 w; w.x = cvtpk(h[0], h[1]); w.y = cvtpk(h[2], h[3]); w.z = cvtpk(h[4], h[5]); w.w = cvtpk(h[6], h[7]);
            *(u32x4*)(HB + (size_t)row * DFF + hcol) = w;
        EPI_ROWS_END
    }
};
struct EpiStoreBf16 {
    bf16_t* PP;
    __device__ __forceinline__ void operator()(const Acc& acc, const Unit& u, int wr, int wc, int fr, int fq) const {
        const int col = u.pn * 256 + 64 * wc + 16 * fq;
        EPI_ROWS_BEGIN
            store_bf16x16(PP + (size_t)row * DM + col, v);
        EPI_ROWS_END
    }
};
struct EpiPle {
    const float* rssp; const bf16_t* PP; const bf16_t* xb; float* out;
    __device__ __forceinline__ void operator()(const Acc& acc, const Unit& u, int wr, int wc, int fr, int fq) const {
        const int col = u.pn * 256 + 64 * wc + 16 * fq;
        EPI_ROWS_BEGIN
            const float rs = rstd_from_parts(rssp, row); const float kexp = -1.4426950408889634f * rs;
            const u32x4* pp = (const u32x4*)(PP + (size_t)row * DM + col); const u32x4* xp = (const u32x4*)(xb + (size_t)row * DM + col);
            const u32x4 p0 = pp[0], p1 = pp[1], x0 = xp[0], x1 = xp[1];
            const unsigned pw[8] = {p0.x, p0.y, p0.z, p0.w, p1.x, p1.y, p1.z, p1.w}, xw[8] = {x0.x, x0.y, x0.z, x0.w, x1.x, x1.y, x1.z, x1.w};
#pragma unroll
            for (int c = 0; c < 8; ++c) {
                v[2 * c] = __builtin_fmaf(__builtin_amdgcn_rcpf(1.0f + __builtin_amdgcn_exp2f(v[2 * c] * kexp)), __builtin_bit_cast(float, pw[c] << 16), __builtin_bit_cast(float, xw[c] << 16));
                v[2 * c + 1] = __builtin_fmaf(__builtin_amdgcn_rcpf(1.0f + __builtin_amdgcn_exp2f(v[2 * c + 1] * kexp)), __builtin_bit_cast(float, pw[c] & 0xffff0000u), __builtin_bit_cast(float, xw[c] & 0xffff0000u)); }
            f32x4* op = (f32x4*)(out + (size_t)row * DM + col);
#pragma unroll
            for (int q = 0; q < 4; ++q) op[q] = (f32x4){v[4 * q], v[4 * q + 1], v[4 * q + 2], v[4 * q + 3]};
        EPI_ROWS_END
    }
};

struct Args {
    const float* in[26]; const int* pos; float* out; unsigned char* ws;
    float inv_freq[8];
    int ph_lo, ph_hi;
};

__device__ __forceinline__ float wave_sum(float v) {
#pragma unroll
    for (int o = 1; o < 64; o <<= 1) v += __shfl_xor(v, o);
    return v;
}
__device__ __forceinline__ int srccol_win(int L) { if (L < 1280) return L; if (L < 4864) return L + 24; if (L < 4888) return 1280 + (L - 4864); return -1; }
__device__ __forceinline__ int srccol_ffi(int L) { const int tile = L >> 8, l = L & 255, wq = l >> 4, jj = l & 15; const int hid = tile * 128 + wq * 8 + (jj & 7); return (jj < 8 ? 0 : DFF) + hid; }
template <int MAP>
__device__ __forceinline__ void transpose_item(const float* W, int K, int ldw, int nvalid, const float* gain, bf16_t* WT, LAS float* scr, int item, int nblk, int lane) {
    const int kb = item / nblk, nb = item % nblk, k0 = 32 * kb, n0 = 64 * nb;
    const int L = n0 + lane; const int sc = MAP == 1 ? srccol_win(L) : MAP == 2 ? srccol_ffi(L) : (L < nvalid ? L : -1);
#pragma unroll 8
    for (int i = 0; i < 32; ++i) { float x = sc >= 0 ? __builtin_nontemporal_load(W + (size_t)(k0 + i) * ldw + sc) : 0.f; if (gain) x *= gain[k0 + i]; scr[i * 65 + lane] = x; }
    asm volatile("s_waitcnt lgkmcnt(0)" ::: "memory");
    const int ch = lane & 3;
#pragma unroll
    for (int j = 0; j < 4; ++j) { const int nn = (lane >> 2) + 16 * j; const LAS float* s = scr + (8 * ch) * 65 + nn;
        u32x4 o; o.x = cvtpk(s[0], s[65]); o.y = cvtpk(s[2 * 65], s[3 * 65]); o.z = cvtpk(s[4 * 65], s[5 * 65]); o.w = cvtpk(s[6 * 65], s[7 * 65]);
        *(u32x4*)(WT + (size_t)phys_col(n0 + nn) * K + k0 + 8 * ch) = o; }
    asm volatile("s_waitcnt lgkmcnt(0)" ::: "memory");
}

__device__ __forceinline__ void p0_prologue(const Args& a, LAS unsigned char* lds, int tid, int lane, int wave) {
    unsigned char* ws = a.ws;
    LAS float* scr = (LAS float*)(lds + wave * 16384);
    const int gw = (int)blockIdx.x * 8 + wave, NGW = (int)gridDim.x * 8;
    constexpr int I_WIN = 32 * 80, I_UP = 16 * 16, I_OUT = 32 * 16, I_FFI = 32 * 88, I_FFO = 88 * 16, I_PG = 32 * 16, I_PP = 8 * 16, I_C1 = 64 * 4, I_C2 = 8 * 4;
    constexpr int NIT = I_WIN + 2 * I_UP + I_OUT + I_FFI + I_FFO + I_PG + I_PP + 2 * I_C1 + 2 * I_C2;
    for (int it0 = gw; it0 < NIT * NREP(0); it0 += NGW) {
        int r = it0 % NIT;
        if (r < I_WIN) { transpose_item<1>(a.in[4], 1024, IN_COLS, 0, a.in[3], (bf16_t*)(ws + WS_WIN), scr, r, 80, lane); continue; } r -= I_WIN;
        if (r < I_FFI) { transpose_item<2>(a.in[21], 1024, 2 * DFF, 0, a.in[20], (bf16_t*)(ws + WS_WFFI), scr, r, 88, lane); continue; } r -= I_FFI;
        if (r < I_FFO) { transpose_item<0>(a.in[22], DFF, 1024, 1024, nullptr, (bf16_t*)(ws + WS_WFFO), scr, r, 16, lane); continue; } r -= I_FFO;
        if (r < I_OUT) { transpose_item<0>(a.in[19], 1024, 1024, 1024, nullptr, (bf16_t*)(ws + WS_WOUT), scr, r, 16, lane); continue; } r -= I_OUT;
        if (r < I_PG) { transpose_item<0>(a.in[24], 1024, 1024, 1024, a.in[23], (bf16_t*)(ws + WS_WPG), scr, r, 16, lane); continue; } r -= I_PG;
        if (r < I_UP) { transpose_item<0>(a.in[17], 512, 1024, 1024, nullptr, (bf16_t*)(ws + WS_WUPN), scr, r, 16, lane); continue; } r -= I_UP;
        if (r < I_UP) { transpose_item<0>(a.in[18], 512, 1024, 1024, nullptr, (bf16_t*)(ws + WS_WUPM), scr, r, 16, lane); continue; } r -= I_UP;
        if (r < I_PP) { transpose_item<0>(a.in[25], 256, 1024, 1024, nullptr, (bf16_t*)(ws + WS_WPP), scr, r, 16, lane); continue; } r -= I_PP;
        if (r < I_C1) { transpose_item<0>(a.in[11], 2048, 256, 256, nullptr, (bf16_t*)(ws + WS_WCK1), scr, r, 4, lane); continue; } r -= I_C1;
        if (r < I_C1) { transpose_item<0>(a.in[13], 2048, 256, 256, nullptr, (bf16_t*)(ws + WS_WCV1), scr, r, 4, lane); continue; } r -= I_C1;
        if (r < I_C2) { transpose_item<0>(a.in[12], 256, 64, 64, nullptr, (bf16_t*)(ws + WS_WCK2), scr, r, 4, lane); continue; } r -= I_C2;
        transpose_item<0>(a.in[14], 256, 64, 64, nullptr, (bf16_t*)(ws + WS_WCV2), scr, r, 4, lane);
    }
    {
        const float* x = a.in[0]; bf16_t* XB = (bf16_t*)(ws + WS_XB); float* rstd0 = (float*)(ws + WS_RSTD0);
        const float* p = a.in[1]; bf16_t* PB = (bf16_t*)(ws + WS_PB);
        for (int m0 = gw; m0 < T * NREP(0); m0 += NGW) { const int m = m0 % T;
            const f32x4* xr = (const f32x4*)(x + (size_t)m * DM) + lane; f32x4 v[4]; float s = 0.f;
#pragma unroll
            for (int j = 0; j < 4; ++j) { v[j] = __builtin_nontemporal_load(xr + 64 * j); s += (v[j].x * v[j].x + v[j].y * v[j].y) + (v[j].z * v[j].z + v[j].w * v[j].w); }
            const f32x4 pv = __builtin_nontemporal_load((const f32x4*)(p + (size_t)m * PLE) + lane);
            s = wave_sum(s);
            if (lane == 0) rstd0[m] = rsqrtf(s * (1.0f / DM) + EPS);
            u32x2* o8 = (u32x2*)(XB + (size_t)m * DM) + lane;
#pragma unroll
            for (int j = 0; j < 4; ++j) o8[64 * j] = (u32x2){cvtpk(v[j].x, v[j].y), cvtpk(v[j].z, v[j].w)};
            ((u32x2*)(PB + (size_t)m * PLE))[lane] = (u32x2){cvtpk(pv.x, pv.y), cvtpk(pv.z, pv.w)};
        }
    }
    {
        float* rope = (float*)(ws + WS_ROPE); const int gt = (int)blockIdx.x * 512 + tid, NGT = (int)gridDim.x * 512;
        const float f0 = a.inv_freq[0], f1 = a.inv_freq[1], f2 = a.inv_freq[2], f3 = a.inv_freq[3], f4 = a.inv_freq[4], f5 = a.inv_freq[5], f6 = a.inv_freq[6], f7 = a.inv_freq[7];
        for (int row0 = gt; row0 < T * NREP(0); row0 += NGT) { const int row = row0 % T; const float pf = (float)a.pos[row]; const float fr8[8] = {f0, f1, f2, f3, f4, f5, f6, f7}; float cs[8], sn[8];
#pragma unroll
            for (int j = 0; j < 8; ++j) { const float ang = pf * fr8[j]; double rev = (double)ang * 0.15915494309189535; rev -= floor(rev); const float fr = (float)rev;
                cs[j] = __builtin_amdgcn_cosf(fr); sn[j] = __builtin_amdgcn_sinf(fr); }
            f32x4* o = (f32x4*)(rope + (size_t)row * 16);
            o[0] = (f32x4){cs[0], cs[1], cs[2], cs[3]}; o[1] = (f32x4){cs[4], cs[5], cs[6], cs[7]}; o[2] = (f32x4){sn[0], sn[1], sn[2], sn[3]}; o[3] = (f32x4){sn[4], sn[5], sn[6], sn[7]}; }
    }
    {
        float* pb = (float*)(ws + WS_PBIAS);
        for (int it = gw; it < 64; it += NGW) { const int kv = it >> 5, kc = it & 31; const float* pe = kv ? a.in[10] : a.in[9]; const float* w1 = kv ? a.in[13] : a.in[11];
            float s0 = 0.f, s1 = 0.f, s2 = 0.f, s3 = 0.f;
            for (int kk = 0; kk < 64; ++kk) { const int k = kc * 64 + kk; const float pv = pe[k]; const float* wr = w1 + (size_t)k * 256 + lane;
                s0 += pv * wr[0]; s1 += pv * wr[64]; s2 += pv * wr[128]; s3 += pv * wr[192]; }
            float* o = pb + (size_t)(kv * 32 + kc) * 256 + lane; o[0] = s0; o[64] = s1; o[128] = s2; o[192] = s3; }
    }
}

__device__ __forceinline__ void kmean_phase(const Args& a, int lane, int wave) {
    const bf16_t* KM = (const bf16_t*)(a.ws + WS_KM); float* KMEAN = (float*)(a.ws + WS_KMEAN);
    const int gw = (int)blockIdx.x * 8 + wave, NGW = (int)gridDim.x * 8;
    for (int it0 = gw; it0 < NB * MOBA_H * 8 * NREP(2); it0 += NGW) { const int it = it0 % (NB * MOBA_H * 8);
        const u32x4* src = (const u32x4*)(KM + (size_t)it * 256 * 64) + lane; float s[8];
#pragma unroll
        for (int c = 0; c < 8; ++c) s[c] = 0.f;
#pragma unroll 8
        for (int i = 0; i < 32; ++i) { const u32x4 w = src[64 * i]; const unsigned ww[4] = {w.x, w.y, w.z, w.w};
#pragma unroll
            for (int c = 0; c < 4; ++c) { s[2 * c] += __builtin_bit_cast(float, ww[c] << 16); s[2 * c + 1] += __builtin_bit_cast(float, ww[c] & 0xffff0000u); } }
#pragma unroll
        for (int c = 0; c < 8; ++c) { s[c] += __shfl_xor(s[c], 8); s[c] += __shfl_xor(s[c], 16); s[c] += __shfl_xor(s[c], 32); }
        if (lane < 8) { f32x4* o = (f32x4*)(KMEAN + (size_t)it * 64 + lane * 8);
            o[0] = (f32x4){s[0], s[1], s[2], s[3]} * (1.0f / 256.0f); o[1] = (f32x4){s[4], s[5], s[6], s[7]} * (1.0f / 256.0f); }
    }
}

constexpr int KROW = 144, VROW = 192;
constexpr int L_K = 0, L_V = 2 * 64 * KROW, L_IMP = L_V + 2 * 64 * VROW, L_SEL = L_IMP + 4 * 64 * 33 * 4, L_KMEAN = L_SEL + 256, L_Q = L_KMEAN + 2048, L_Y = L_Q + 64, L_ATT_END = L_Y + 65536;
static_assert(L_ATT_END <= 147456, "attention LDS");
struct AttnState { float m, l; f32x16 o[2]; f32x16 negm; };
__device__ __forceinline__ void attn_reset(AttnState& st) { st.m = 0.f; st.l = 0.f;
#pragma unroll
    for (int r = 0; r < 16; ++r) { st.o[0][r] = 0.f; st.o[1][r] = 0.f; st.negm[r] = 0.f; } }
__device__ __forceinline__ s16x4 vtr(const LAS unsigned char* p) { return __builtin_bit_cast(s16x4, __builtin_amdgcn_ds_read_tr16_b64_v4i16((LAS s16x4*)p)); }
__device__ __forceinline__ void pv_subtile(AttnState& st, const LAS unsigned char* vb, const f32x16& p) {
    u32x4 w0, w1; w0.x = cvtpk(p[0], p[1]); w0.y = cvtpk(p[2], p[3]); w0.z = cvtpk(p[4], p[5]); w0.w = cvtpk(p[6], p[7]);
    w1.x = cvtpk(p[8], p[9]); w1.y = cvtpk(p[10], p[11]); w1.z = cvtpk(p[12], p[13]); w1.w = cvtpk(p[14], p[15]);
    const bf16x8 pf0 = __builtin_bit_cast(bf16x8, w0), pf1 = __builtin_bit_cast(bf16x8, w1);
#pragma unroll
    for (int dh = 0; dh < 2; ++dh) {
        const s16x4 a0 = vtr(vb + dh * 64), a1 = vtr(vb + dh * 64 + 8 * VROW), b0 = vtr(vb + dh * 64 + 16 * VROW), b1 = vtr(vb + dh * 64 + 24 * VROW);
        const bf16x8 vf0 = {a0[0], a0[1], a0[2], a0[3], a1[0], a1[1], a1[2], a1[3]}, vf1 = {b0[0], b0[1], b0[2], b0[3], b1[0], b1[1], b1[2], b1[3]};
        st.o[dh] = __builtin_amdgcn_mfma_f32_32x32x16_bf16(vf0, pf0, st.o[dh], 0, 0, 0);
        st.o[dh] = __builtin_amdgcn_mfma_f32_32x32x16_bf16(vf1, pf1, st.o[dh], 0, 0, 0);
    }
}
struct VFrags { s16x4 f[2][4]; };
__device__ __forceinline__ VFrags v_preload(const LAS unsigned char* vb) { VFrags v;
#pragma unroll
    for (int dh = 0; dh < 2; ++dh) { v.f[dh][0] = vtr(vb + dh * 64); v.f[dh][1] = vtr(vb + dh * 64 + 8 * VROW); v.f[dh][2] = vtr(vb + dh * 64 + 16 * VROW); v.f[dh][3] = vtr(vb + dh * 64 + 24 * VROW); }
    return v; }
__device__ __forceinline__ void pv_subtile_pre(AttnState& st, const VFrags& v, const f32x16& p) {
    u32x4 w0, w1; w0.x = cvtpk(p[0], p[1]); w0.y = cvtpk(p[2], p[3]); w0.z = cvtpk(p[4], p[5]); w0.w = cvtpk(p[6], p[7]);
    w1.x = cvtpk(p[8], p[9]); w1.y = cvtpk(p[10], p[11]); w1.z = cvtpk(p[12], p[13]); w1.w = cvtpk(p[14], p[15]);
    const bf16x8 pf0 = __builtin_bit_cast(bf16x8, w0), pf1 = __builtin_bit_cast(bf16x8, w1);
#pragma unroll
    for (int dh = 0; dh < 2; ++dh) {
        const s16x4 a0 = v.f[dh][0], a1 = v.f[dh][1], b0 = v.f[dh][2], b1 = v.f[dh][3];
        const bf16x8 vf0 = {a0[0], a0[1], a0[2], a0[3], a1[0], a1[1], a1[2], a1[3]}, vf1 = {b0[0], b0[1], b0[2], b0[3], b1[0], b1[1], b1[2], b1[3]};
        st.o[dh] = __builtin_amdgcn_mfma_f32_32x32x16_bf16(vf0, pf0, st.o[dh], 0, 0, 0);
        st.o[dh] = __builtin_amdgcn_mfma_f32_32x32x16_bf16(vf1, pf1, st.o[dh], 0, 0, 0);
    }
}
__device__ __forceinline__ void attn_tile(const LAS unsigned char* kb, const LAS unsigned char* vb, const bf16x8 (&q)[4], AttnState& st, bool rowok, int lo, int hi, int lane) {
    const int r32 = lane & 31, h = lane >> 5;
    const bool live = rowok && lo <= hi && hi >= 0 && lo <= 63;
    if (!__any(live)) return;
    const bool full = rowok && lo <= 0 && hi >= 63;
    const bool rowmask_only = __all(full || !live);
    const float cm = (rowmask_only && !full) ? -INFINITY : 0.f;
    f32x16 cinit;
#pragma unroll
    for (int r = 0; r < 16; ++r) cinit[r] = st.negm[r] + cm;
    const LAS unsigned char* kp = kb + r32 * KROW + h * 16;
    f32x16 s0, s1;
    { const bf16x8 k0 = *(const LAS bf16x8*)(kp), k1 = *(const LAS bf16x8*)(kp + 32 * KROW);
      s0 = __builtin_amdgcn_mfma_f32_32x32x16_bf16(k0, q[0], cinit, 0, 0, 0);
      s1 = __builtin_amdgcn_mfma_f32_32x32x16_bf16(k1, q[0], cinit, 0, 0, 0); }
#pragma unroll
    for (int ks = 1; ks < 4; ++ks) {
        const bf16x8 k0 = *(const LAS bf16x8*)(kp + ks * 32), k1 = *(const LAS bf16x8*)(kp + 32 * KROW + ks * 32);
        s0 = __builtin_amdgcn_mfma_f32_32x32x16_bf16(k0, q[ks], s0, 0, 0, 0);
        s1 = __builtin_amdgcn_mfma_f32_32x32x16_bf16(k1, q[ks], s1, 0, 0, 0);
    }
    const LAS unsigned char* vp = vb + (4 * h + ((lane & 15) >> 2)) * VROW + (16 * ((lane >> 4) & 1) + 4 * (lane & 3)) * 2;
    const VFrags vf0 = v_preload(vp);
    __builtin_amdgcn_sched_barrier(0);
    if (!rowmask_only) {
#pragma unroll
        for (int r = 0; r < 16; ++r) { const int kk = (r & 3) + 8 * (r >> 2) + 4 * h;
            if (!(live && kk >= lo && kk <= hi)) s0[r] = -INFINITY;
            if (!(live && kk + 32 >= lo && kk + 32 <= hi)) s1[r] = -INFINITY; }
    }
    float mx = fmaxf(fmaxf(s0[0], s1[0]), fmaxf(s0[1], s1[1]));
#pragma unroll
    for (int r = 2; r < 16; r += 2) mx = fmaxf(fmaxf(mx, s0[r]), fmaxf(s1[r], fmaxf(s0[r + 1], s1[r + 1])));
    mx = fmaxf(mx, swap32(mx));
    if (__any(mx > 8.0f)) {
        const float d = fmaxf(mx, 0.f), alpha = __builtin_amdgcn_exp2f(-d);
        st.m += d; st.l *= alpha;
#pragma unroll
        for (int r = 0; r < 16; ++r) { s0[r] -= d; s1[r] -= d; st.o[0][r] *= alpha; st.o[1][r] *= alpha; st.negm[r] = -st.m; }
    }
    float ls0 = 0.f, ls1 = 0.f;
#pragma unroll
    for (int r = 0; r < 16; ++r) { s0[r] = __builtin_amdgcn_exp2f(s0[r]); s1[r] = __builtin_amdgcn_exp2f(s1[r]); ls0 += s0[r]; ls1 += s1[r]; }
    st.l += ls0 + ls1;
    const VFrags vf1 = v_preload(vp + 32 * VROW);
    pv_subtile_pre(st, vf0, s0);
    pv_subtile_pre(st, vf1, s1);
}
template <bool FIRST>
__device__ __forceinline__ void attn_fold(LAS float* yl, const AttnState& st, float gate) {
    const float lt = st.l + swap32(st.l); const float f = lt > 0.f ? gate / lt : 0.f;
#pragma unroll
    for (int dh = 0; dh < 2; ++dh)
#pragma unroll
        for (int r = 0; r < 16; ++r) { float v = f * st.o[dh][r]; if (!FIRST) v += yl[(dh * 16 + r) * 512]; yl[(dh * 16 + r) * 512] = v; }
}
struct KVRegs { u32x4 k, v; };
__device__ __forceinline__ KVRegs kv_load(const unsigned char* Kg, const unsigned char* Vg, int tile, int tid) {
    KVRegs r; r.k = *(const u32x4*)(Kg + (size_t)tile * 8192 + tid * 16); r.v = *(const u32x4*)(Vg + (size_t)tile * 8192 + tid * 16); return r; }
__device__ __forceinline__ void kv_store(LAS unsigned char* lds, const KVRegs& r, int buf, int tid) {
    *(LAS u32x4*)(lds + L_K + buf * 64 * KROW + (tid >> 3) * KROW + (tid & 7) * 16) = r.k;
    *(LAS u32x4*)(lds + L_V + buf * 64 * VROW + (tid >> 3) * VROW + (tid & 7) * 16) = r.v; }
#define LDS_BAR() asm volatile("s_waitcnt lgkmcnt(0)\n\ts_barrier" ::: "memory")
template <class MF>
__device__ __forceinline__ void attn_pass(LAS unsigned char* lds, const unsigned char* Kg, const unsigned char* Vg, int t_lo, int t_hi, const bf16x8 (&q)[4], AttnState& st, const MF& mf, int tid, int lane) {
    const int n = t_hi - t_lo + 1;
    KVRegs rA = kv_load(Kg, Vg, t_lo, tid), rB = rA;
    if (n > 1) rB = kv_load(Kg, Vg, t_lo + 1, tid);
    for (int i = 0; i < n; i += 2) {
        kv_store(lds, rA, 0, tid);
        LDS_BAR();
        if (i + 2 < n) rA = kv_load(Kg, Vg, t_lo + i + 2, tid);
        { bool rowok; int lo, hi; mf(t_lo + i, rowok, lo, hi);
          attn_tile(lds + L_K, lds + L_V, q, st, rowok, lo, hi, lane); }
        if (i + 1 < n) {
            kv_store(lds, rB, 1, tid);
            LDS_BAR();
            if (i + 3 < n) rB = kv_load(Kg, Vg, t_lo + i + 3, tid);
            bool rowok; int lo, hi; mf(t_lo + i + 1, rowok, lo, hi);
            attn_tile(lds + L_K + 64 * KROW, lds + L_V + 64 * VROW, q, st, rowok, lo, hi, lane);
        }
    }
    __syncthreads();
}
__device__ __forceinline__ void store_y(bf16_t* dst, const f32x16 (&y)[2], int h) {
#pragma unroll
    for (int dh = 0; dh < 2; ++dh)
#pragma unroll
        for (int g4 = 0; g4 < 4; ++g4) *(u32x2*)(dst + 32 * dh + 8 * g4 + 4 * h) = (u32x2){cvtpk(y[dh][4 * g4], y[dh][4 * g4 + 1]), cvtpk(y[dh][4 * g4 + 2], y[dh][4 * g4 + 3])};
}

__device__ __forceinline__ void nsa_unit(const Args& a, LAS unsigned char* lds, int b, int g, int qc, int tid, int lane, int wave) {
    unsigned char* ws = a.ws;
    const int r32 = lane & 31, h = lane >> 5, hl = wave >> 1, head = g * 4 + hl, tt = 32 * (wave & 1) + r32, t = 64 * qc + tt;
    const size_t row = (size_t)b * SEQ + t; const int bg = b * 2 + g;
    bf16x8 q[4];
    { const bf16_t* qp = (const bf16_t*)(ws + WS_QN) + ((size_t)(b * 8 + head) * SEQ + t) * 64 + 8 * h;
#pragma unroll
      for (int ks = 0; ks < 4; ++ks) q[ks] = *(const bf16x8*)(qp + 16 * ks); }
    const float* gn = (const float*)(ws + WS_GN) + row * 32 + head * 3; const float g_c = gn[0], g_s = gn[1], g_w = gn[2];
    LAS float* yl = (LAS float*)(lds + L_Y) + tid;
    {
        const unsigned char* Kg = ws + WS_KCC + (size_t)bg * 128 * 128; const unsigned char* Vg = ws + WS_VCC + (size_t)bg * 128 * 128;
#pragma unroll
        for (int i = 0; i < 2; ++i) { const int idx = tid + 512 * i; const u32x4 kk = *(const u32x4*)(Kg + idx * 16), vv = *(const u32x4*)(Vg + idx * 16);
            *(LAS u32x4*)(lds + L_K + (idx >> 3) * KROW + (idx & 7) * 16) = kk; *(LAS u32x4*)(lds + L_V + (idx >> 3) * VROW + (idx & 7) * 16) = vv; }
        __syncthreads();
        const int cmax = t >= 31 ? ((t - 31) >> 4) : -1;
        f32x16 s[4];
        const LAS unsigned char* kp = lds + L_K + r32 * KROW + h * 16;
#pragma unroll
        for (int p = 0; p < 4; ++p) {
#pragma unroll
            for (int r = 0; r < 16; ++r) s[p][r] = 0.f;
#pragma unroll
            for (int ks = 0; ks < 4; ++ks) s[p] = __builtin_amdgcn_mfma_f32_32x32x16_bf16(*(const LAS bf16x8*)(kp + p * 32 * KROW + ks * 32), q[ks], s[p], 0, 0, 0);
        }
        float mx = -INFINITY;
#pragma unroll
        for (int p = 0; p < 4; ++p)
#pragma unroll
            for (int r = 0; r < 16; ++r) { const int c = 32 * p + (r & 3) + 8 * (r >> 2) + 4 * h; if (c > cmax) s[p][r] = -INFINITY; mx = fmaxf(mx, s[p][r]); }
        mx = fmaxf(mx, swap32(mx));
        const float msafe = (mx == -INFINITY) ? 0.f : mx; float ls = 0.f;
#pragma unroll
        for (int p = 0; p < 4; ++p)
#pragma unroll
            for (int r = 0; r < 16; ++r) { s[p][r] = __builtin_amdgcn_exp2f(s[p][r] - msafe); ls += s[p][r]; }
        ls += swap32(ls);
        const float inv = 1.0f / fmaxf(ls, 1e-30f);
#pragma unroll
        for (int p = 0; p < 4; ++p)
#pragma unroll
            for (int r = 0; r < 16; ++r) s[p][r] *= inv;
        LAS float* imp = (LAS float*)(lds + L_IMP) + (hl * 64 + tt) * 33;
        AttnState st; attn_reset(st);
        const LAS unsigned char* vp = lds + L_V + (4 * h + ((lane & 15) >> 2)) * VROW + (16 * ((lane >> 4) & 1) + 4 * (lane & 3)) * 2;
        float eprev = 0.f;
#pragma unroll
        for (int p = 0; p < 4; ++p) {
#pragma unroll
            for (int g4 = 0; g4 < 4; ++g4) {
                const float Gv = (s[p][4 * g4] + s[p][4 * g4 + 1]) + (s[p][4 * g4 + 2] + s[p][4 * g4 + 3]);
                const float esw = swap32(s[p][4 * g4 + 3]);
                imp[8 * p + 2 * g4 + h] = Gv + (h ? esw : eprev);
                eprev = esw;
            }
            pv_subtile(st, vp + p * 32 * VROW, s[p]);
        }
#pragma unroll
        for (int dh = 0; dh < 2; ++dh)
#pragma unroll
            for (int r = 0; r < 16; ++r) yl[(dh * 16 + r) * 512] = g_c * st.o[dh][r];
        __syncthreads();
        {
            const int tok = tid >> 3, sub = tid & 7, cur = qc; unsigned msk;
            if (cur - 2 <= 5) msk = (cur >= 31) ? 0xffffffffu : ((1u << (cur + 1)) - 1u);
            else {
                const LAS float* ip = (const LAS float*)(lds + L_IMP) + tok * 33 + sub * 4;
                float v4[4];
#pragma unroll
                for (int jj = 0; jj < 4; ++jj) { const int j = sub * 4 + jj; const float vj = ((ip[jj] + ip[64 * 33 + jj]) + ip[2 * 64 * 33 + jj]) + ip[3 * 64 * 33 + jj]; v4[jj] = (j >= 1 && j <= cur - 2) ? vj : -1.f; }
                msk = 1u | (1u << cur) | (1u << (cur - 1));
#pragma unroll
                for (int pick = 0; pick < 5; ++pick) {
                    float bv = v4[0]; int bj = sub * 4;
#pragma unroll
                    for (int jj = 1; jj < 4; ++jj) if (v4[jj] > bv) { bv = v4[jj]; bj = sub * 4 + jj; }
#pragma unroll
                    for (int off = 1; off < 8; off <<= 1) { const float ov = __shfl_xor(bv, off); const int oj = __shfl_xor(bj, off); if (ov > bv || (ov == bv && oj < bj)) { bv = ov; bj = oj; } }
                    msk |= 1u << bj;
#pragma unroll
                    for (int jj = 0; jj < 4; ++jj) if (sub * 4 + jj == bj) v4[jj] = -1.f;
                }
            }
            if (sub == 0) ((LAS unsigned*)(lds + L_SEL))[tok] = msk;
        }
        __syncthreads();
    }
    const unsigned selm = ((const LAS unsigned*)(lds + L_SEL))[tt];
    {
        AttnState st; attn_reset(st);
        auto mf = [&](int j, bool& rowok, int& lo, int& hi) { rowok = (selm >> j) & 1u; lo = 0; hi = (j == qc) ? tt : 63; };
        attn_pass(lds, ws + WS_KS + (size_t)bg * SEQ * 128, ws + WS_VS + (size_t)bg * SEQ * 128, 0, qc, q, st, mf, tid, lane);
        attn_fold<false>(yl, st, g_s);
    }
    {
        AttnState st; attn_reset(st);
        const int jl = qc - 8;
        auto mf = [&](int j, bool& rowok, int& lo, int& hi) { rowok = true; lo = (j == jl) ? tt + 1 : 0; hi = (j == qc) ? tt : 63; };
        attn_pass(lds, ws + WS_KW + (size_t)bg * SEQ * 128, ws + WS_VW + (size_t)bg * SEQ * 128, jl < 0 ? 0 : jl, qc, q, st, mf, tid, lane);
        attn_fold<false>(yl, st, g_w);
    }
    f32x16 y[2];
#pragma unroll
    for (int dh = 0; dh < 2; ++dh)
#pragma unroll
        for (int r = 0; r < 16; ++r) y[dh][r] = yl[(dh * 16 + r) * 512];
    store_y((bf16_t*)(ws + WS_YN) + row * 512 + head * 64, y, h);
}

__device__ __forceinline__ void moba_unit(const Args& a, LAS unsigned char* lds, int b, int hd, int own, int tid, int lane, int wave) {
    unsigned char* ws = a.ws;
    const int r32 = lane & 31, h = lane >> 5, tb = 32 * wave + r32, t = 256 * own + tb;
    const size_t row = (size_t)b * SEQ + t; const int bh = b * 8 + hd;
    bf16x8 q[4];
    { const bf16_t* qp = (const bf16_t*)(ws + WS_QM) + ((size_t)bh * SEQ + t) * 64 + 8 * h;
#pragma unroll
      for (int ks = 0; ks < 4; ++ks) q[ks] = *(const bf16x8*)(qp + 16 * ks); }
    unsigned msk;
    if (own <= 3) msk = (1u << own) - 1u;
    else {
        { const float* km = (const float*)(ws + WS_KMEAN) + (size_t)bh * 8 * 64; ((LAS float*)(lds + L_KMEAN))[tid] = km[tid]; }
        __syncthreads();
        float sc[7];
#pragma unroll
        for (int n = 0; n < 7; ++n) { float d = 0.f;
            if (n < own) {
                const LAS float* kmn = (const LAS float*)(lds + L_KMEAN) + n * 64 + 8 * h;
#pragma unroll
                for (int ks = 0; ks < 4; ++ks)
#pragma unroll
                    for (int j = 0; j < 8; ++j) d += bf2f((unsigned short)q[ks][j]) * kmn[16 * ks + j];
                d += swap32(d);
            }
            sc[n] = d; }
        msk = 0u;
        for (int pick = 0; pick < 3; ++pick) { int best = 0; float bv = -INFINITY;
#pragma unroll
            for (int n = 0; n < 7; ++n) if (n < own && !((msk >> n) & 1u) && sc[n] > bv) { bv = sc[n]; best = n; }
            msk |= 1u << best; }
        __syncthreads();
    }
    AttnState st; attn_reset(st);
    auto mf = [&](int kt, bool& rowok, int& lo, int& hi) { const int n = kt >> 2; lo = 0;
        if (n < own) { rowok = (msk >> n) & 1u; hi = 63; } else { rowok = true; const int d = tb - 64 * (kt & 3); hi = d > 63 ? 63 : d; } };
    attn_pass(lds, ws + WS_KM + (size_t)bh * SEQ * 128, ws + WS_VM + (size_t)bh * SEQ * 128, 0, 4 * own + 3, q, st, mf, tid, lane);
    { const float lt = st.l + swap32(st.l); const float f = lt > 0.f ? 1.0f / lt : 0.f;
#pragma unroll
      for (int r = 0; r < 16; ++r) { st.o[0][r] *= f; st.o[1][r] *= f; } }
    store_y((bf16_t*)(ws + WS_YM) + row * 512 + hd * 64, st.o, h);
}

__device__ __forceinline__ bool decode_unit(int u, int& type, int& par, int& sub) {
    if (u < 1024) { type = 1; par = 7 - (u >> 7); sub = u & 127; return true; }
    u -= 1024;
    if (u < 1024) { type = 0; par = 31 - (u >> 5); sub = u & 31; return true; }
    return false;
}
__device__ __forceinline__ void attention_phase(const Args& a, LAS unsigned char* lds, int tid, int lane, int wave, int rep) {
    unsigned* ctr = (unsigned*)(a.ws + WS_CTL) + rep;
    unsigned* cflag = (unsigned*)(a.ws + WS_CTL) + 16 + rep;
    if (blockIdx.x < 32) {
        unsigned char* ws = a.ws;
        { SchedCmp S{(const char*)(ws + WS_KC), (const char*)(ws + WS_VC), (const char*)(ws + WS_WCK1), (const char*)(ws + WS_WCV1), (size_t)256 * 1024 * 2};
          EpiCmp1 E{(const float*)(ws + WS_B1), (bf16_t*)(ws + WS_HID)};
          pg8::gemm_phase(lds, 2048, 1024, 2048, S, E); }
        asm volatile("s_waitcnt vmcnt(0)" ::: "memory"); __builtin_amdgcn_fence(__ATOMIC_RELEASE, "agent"); __syncthreads(); __builtin_amdgcn_fence(__ATOMIC_ACQUIRE, "agent");
        { SchedCmp S{(const char*)(ws + WS_HID), (const char*)(ws + WS_HID) + (size_t)4096 * 256 * 2, (const char*)(ws + WS_WCK2), (const char*)(ws + WS_WCV2), (size_t)256 * 256 * 2};
          EpiCmp2 E{a.in[6], (const float*)(ws + WS_ROPE), (bf16_t*)(ws + WS_KCC), (bf16_t*)(ws + WS_VCC)};
          pg8::gemm_phase(lds, 256, 256, 256, S, E); }
        asm volatile("s_waitcnt vmcnt(0)" ::: "memory"); __builtin_amdgcn_fence(__ATOMIC_RELEASE, "agent"); __syncthreads();
        if (tid == 0) __hip_atomic_fetch_add(cflag, 1u, __ATOMIC_RELEASE, __HIP_MEMORY_SCOPE_AGENT);
    }
    bool cmp_ready = false;
    unsigned unext = 0u;
    if (tid == 0) unext = atomicAdd(ctr, 1u);
    for (;;) {
        if (tid == 0) ((LAS unsigned*)(lds + L_Q))[0] = unext;
        __syncthreads();
        const int u = (int)((LAS unsigned*)(lds + L_Q))[0];
        __syncthreads();
        int type, par, sub;
        if (!decode_unit(u, type, par, sub)) break;
        if (tid == 0) unext = atomicAdd(ctr, 1u);
        if (type == 0 && !cmp_ready) {
            if (tid == 0) { unsigned sp = 0; while (__hip_atomic_load(cflag, __ATOMIC_RELAXED, __HIP_MEMORY_SCOPE_AGENT) < 32u) { __builtin_amdgcn_s_sleep(8); if (++sp > (1u << 22)) break; } }
            __syncthreads(); __builtin_amdgcn_fence(__ATOMIC_ACQUIRE, "agent"); cmp_ready = true;
        }
        if (type == 0) nsa_unit(a, lds, sub >> 1, sub & 1, par, tid, lane, wave);
        else moba_unit(a, lds, sub >> 3, sub & 7, par, tid, lane, wave);
    }
}

#define XB_TMO      128
#define XB_XCNT(j)  (256  + 64 * (j))
#define XB_XSUB(j)  (1280 + 64 * (j))
#define XB_XGEN(j)  (2304 + 64 * (j))
#define XB_TOP      3328
#define XB_TOPGEN   3392
#define XCD_BAR_WORDS 3456
#define XB_SPIN_CAP (1u << 18)
__device__ __forceinline__ unsigned xb_ld(unsigned* p)              { return __hip_atomic_load(p, __ATOMIC_RELAXED, __HIP_MEMORY_SCOPE_AGENT); }
__device__ __forceinline__ unsigned xb_add(unsigned* p, unsigned v) { return __hip_atomic_fetch_add(p, v, __ATOMIC_RELAXED, __HIP_MEMORY_SCOPE_AGENT); }
__device__ __forceinline__ unsigned xb_xcc_id() { return (unsigned)__builtin_amdgcn_s_getreg((3 << 11) | 20) & 0xFu; }
#define XB_SPIN(cond, bar) do { unsigned _sp = 0; while (cond) { __builtin_amdgcn_s_sleep(1); \
    if ((++_sp & 255u) == 0u) { if (xb_ld(&(bar)[XB_TMO])) break; if (_sp > XB_SPIN_CAP) { atomicAdd(&(bar)[XB_TMO], 1u); break; } } } } while (0)
struct XcdBarrier { unsigned* bar; unsigned x; volatile LAS unsigned* st; };
__device__ __forceinline__ XcdBarrier xcd_barrier_post(unsigned* bar, volatile LAS unsigned* st) {
    XcdBarrier b; b.bar = bar; b.x = xb_xcc_id(); b.st = st;
    if (threadIdx.x == 0) (void)xb_add(&bar[XB_XCNT(b.x)], 1u);
    return b;
}
__device__ __forceinline__ void xcd_barrier_complete(unsigned* bar, unsigned x, unsigned& nloc, unsigned& nx) {
    const unsigned G = gridDim.x * gridDim.y * gridDim.z;
    unsigned sum, cnt, mine, sp = 0u;
    for (;;) {
        sum = 0u; cnt = 0u; mine = 0u;
#pragma unroll
        for (unsigned j = 0; j < 16; ++j) { const unsigned c = xb_ld(&bar[XB_XCNT(j)]); sum += c; cnt += (c > 0u) ? 1u : 0u; mine = (j == x) ? c : mine; }
        if (sum == G) break;
        __builtin_amdgcn_s_sleep(1);
        if ((++sp & 255u) == 0u) { if (xb_ld(&bar[XB_TMO])) break; if (sp > XB_SPIN_CAP) { atomicAdd(&bar[XB_TMO], 1u); break; } }
    }
    nloc = mine > 0u ? mine : 1u; nx = cnt > 0u ? cnt : 1u;
}
__device__ __forceinline__ void xcd_barrier(const XcdBarrier& b) {
    asm volatile("s_waitcnt vmcnt(0)" ::: "memory");
    __syncthreads();
    if (threadIdx.x == 0) {
        unsigned* bar = b.bar;
        __builtin_amdgcn_s_waitcnt(0);
        unsigned nloc = b.st[0], nx = b.st[1];
        if (nloc == 0u) { xcd_barrier_complete(bar, b.x, nloc, nx); b.st[0] = nloc; b.st[1] = nx; }
        const unsigned old = xb_add(&bar[XB_XSUB(b.x)], 1u);
        const unsigned gen = old / nloc;
        if (old + 1u == (gen + 1u) * nloc) {
            __builtin_amdgcn_fence(__ATOMIC_RELEASE, "agent");
            asm volatile("s_waitcnt vmcnt(0)" ::: "memory");
            const unsigned og = xb_add(&bar[XB_TOP], 1u);
            const unsigned tg = og / nx;
            if (og + 1u == (tg + 1u) * nx) xb_add(&bar[XB_TOPGEN], 1u);
            else XB_SPIN(xb_ld(&bar[XB_TOPGEN]) == tg, bar);
            __builtin_amdgcn_fence(__ATOMIC_ACQUIRE, "agent");
            xb_add(&bar[XB_XGEN(b.x)], 1u);
            asm volatile("s_waitcnt vmcnt(0)" ::: "memory");
        } else {
            XB_SPIN(xb_ld(&bar[XB_XGEN(b.x)]) == gen, bar);
            __builtin_amdgcn_fence(__ATOMIC_ACQUIRE, "agent");
            asm volatile("s_waitcnt vmcnt(0)" ::: "memory");
        }
    }
    __syncthreads();
}

constexpr int NPHASE = 10;
constexpr int LDS_BYTES = 147456, L_MISC = LDS_BYTES - 64;
constexpr int CW_BAR = 1024;
constexpr size_t CTL_ZERO_BYTES = 32768;
__global__ void __launch_bounds__(512) fwd_kernel(Args a) {
    extern __shared__ __attribute__((aligned(16))) unsigned char lds_raw[];
    LAS unsigned char* lds = (LAS unsigned char*)lds_raw;
    const int tid = threadIdx.x, lane = tid & 63, wave = __builtin_amdgcn_readfirstlane(tid >> 6);
    unsigned char* ws = a.ws;
    const int lo = a.ph_lo, hi = a.ph_hi;
#ifndef PH_MASK
#define PH_MASK 0x3ff
#endif
#define IN(k) (((PH_MASK >> (k)) & 1) && lo <= (k) && (k) < hi)
#define SEAM(k) do { if (IN(k) && IN((k) + ((k) == 2 ? 2 : 1))) { xcd_barrier(bar); } } while (0)
    volatile LAS unsigned* misc = (volatile LAS unsigned*)(lds + L_MISC);
    if (tid < 16) misc[tid] = 0u;
    __syncthreads();
    XcdBarrier bar = xcd_barrier_post((unsigned*)(ws + WS_CTL) + CW_BAR, misc);
    if (lo < 0) cg::this_grid().sync();
    if (IN(0)) { p0_prologue(a, lds, tid, lane, wave); }
    SEAM(0);
    if (IN(1)) {
        if (blockIdx.x == 0) { const float* pb = (const float*)(ws + WS_PBIAS); float s = 0.f; const int kv = tid >> 8, n = tid & 255;
            for (int c = 0; c < 32; ++c) s += pb[(size_t)(kv * 32 + c) * 256 + n];
            ((float*)(ws + WS_B1))[tid] = s; }
        SchedStd S; S.init(ws + WS_XB, DM, ws + WS_WIN, DM, T, IN_PAD, NREP(1));
        EpiProj E{(const float*)(ws + WS_RSTD0), (const float*)(ws + WS_ROPE), a.in[5], a.in[7], a.in[8], a.in[15], a.in[16],
                  (bf16_t*)(ws + WS_QN), (bf16_t*)(ws + WS_KC), (bf16_t*)(ws + WS_VC), (bf16_t*)(ws + WS_KS), (bf16_t*)(ws + WS_VS), (bf16_t*)(ws + WS_KW), (bf16_t*)(ws + WS_VW),
                  (bf16_t*)(ws + WS_QM), (bf16_t*)(ws + WS_KM), (bf16_t*)(ws + WS_VM), (bf16_t*)(ws + WS_GA), (bf16_t*)(ws + WS_GB), (float*)(ws + WS_GN)};
        pg8::gemm_phase(lds, DM, DM, DM, S, E);
    }
    SEAM(1);
    if (IN(2)) {
        kmean_phase(a, lane, wave);
        SchedStd S; S.init(ws + WS_PB, PLE, ws + WS_WPP, PLE, T, DM); EpiStoreBf16 E{(bf16_t*)(ws + WS_PP)}; pg8::gemm_phase(lds, PLE, PLE, PLE, S, E);
    }
    SEAM(2);
    if (IN(4)) { for (int rep = 0; rep < NREP(4); ++rep) attention_phase(a, lds, tid, lane, wave, rep); }
    SEAM(4);
    if (IN(5)) {
        SchedMerge S; S.init(ws + WS_YN, ws + WS_YM, ws + WS_WUPN, ws + WS_WUPM, 512, T, DM);
        EpiMerge E{(const bf16_t*)(ws + WS_GA), (const bf16_t*)(ws + WS_GB), (bf16_t*)(ws + WS_MB)};
        pg8::gemm_phase(lds, 512, 512, 512, S, E);
    }
    SEAM(5);
    if (IN(6)) {
        SchedStd S; S.init(ws + WS_MB, DM, ws + WS_WOUT, DM, T, DM);
        EpiResid<true> E{a.in[0], (bf16_t*)(ws + WS_XB), (float*)(ws + WS_RSSP)};
        pg8::gemm_phase(lds, DM, DM, DM, S, E);
    }
    SEAM(6);
    if (IN(7)) {
        SchedStd S; S.init(ws + WS_XB, DM, ws + WS_WFFI, DM, T, 2 * DFF, NREP(7));
        EpiFfnIn E{(const float*)(ws + WS_RSSP), (bf16_t*)(ws + WS_HB)};
        pg8::gemm_phase(lds, DM, DM, DM, S, E);
    }
    SEAM(7);
    if (IN(8)) {
        SchedStd S; S.init(ws + WS_HB, DFF, ws + WS_WFFO, DFF, T, DM);
        EpiResid<false> E{nullptr, (bf16_t*)(ws + WS_XB), (float*)(ws + WS_RSSP)};
        pg8::gemm_phase(lds, DFF, DFF, DFF, S, E);
    }
    SEAM(8);
    if (IN(9)) {
#ifndef NO_P9B
        { SchedStd S; S.init(ws + WS_XB, DM, ws + WS_WPG, DM, T, DM); EpiPle E{(const float*)(ws + WS_RSSP), (const bf16_t*)(ws + WS_PP), (const bf16_t*)(ws + WS_XB), a.out}; pg8::gemm_phase(lds, DM, DM, DM, S, E); }
#endif
    }
#undef IN
#undef SEAM
}

extern "C" void kernel_launch(void* const* d_in, const int* in_sizes, int n_in, void* d_out, int out_size, void* d_ws, size_t ws_size, hipStream_t stream) {
    static int grid = 0;
    if (grid == 0) {
        if (n_in != 26 || out_size != T * DM || ws_size < WS_END) { fprintf(stderr, "kernel_launch: unexpected shapes (n_in %d, out %d, ws %zu)\n", n_in, out_size, ws_size); grid = -1; return; }
        int dev = 0, cus = 0, per_cu = 0;
        hipGetDevice(&dev); hipDeviceGetAttribute(&cus, hipDeviceAttributeMultiprocessorCount, dev);
        if (hipFuncSetAttribute((const void*)fwd_kernel, hipFuncAttributeMaxDynamicSharedMemorySize, LDS_BYTES) != hipSuccess) { fprintf(stderr, "kernel_launch: hipFuncSetAttribute failed\n"); grid = -1; return; }
        if (hipOccupancyMaxActiveBlocksPerMultiprocessor(&per_cu, (const void*)fwd_kernel, 512, LDS_BYTES) != hipSuccess || per_cu < 1) { fprintf(stderr, "kernel_launch: occupancy query gave %d\n", per_cu); per_cu = 1; }
        (void)hipGetLastError();
        grid = cus * 1;
    }
    if (grid < 0) return;
    if (hipMemsetAsync((char*)d_ws + WS_CTL, 0, CTL_ZERO_BYTES, stream) != hipSuccess) { fprintf(stderr, "kernel_launch: memset failed\n"); return; }
    Args a{};
    for (int i = 0; i < 26; ++i) a.in[i] = (const float*)d_in[i];
    a.pos = (const int*)d_in[2]; a.out = (float*)d_out; a.ws = (unsigned char*)d_ws;
    for (int j = 0; j < 8; ++j) a.inv_freq[j] = powf(500000.0f, -(float)j / 8.0f);
#if MK_PER_PHASE
    for (int ph = 0; ph < NPHASE; ++ph) { a.ph_lo = ph; a.ph_hi = ph + 1; hipLaunchKernelGGL(fwd_kernel, dim3(grid), dim3(512), LDS_BYTES, stream, a); }
#else
    a.ph_lo = 0; a.ph_hi = NPHASE;
    void* args[] = {&a};
    hipError_t e = hipLaunchCooperativeKernel((const void*)fwd_kernel, dim3(grid), dim3(512), args, LDS_BYTES, stream);
    if (e != hipSuccess) fprintf(stderr, "cooperative launch failed: %s (grid %d)\n", hipGetErrorString(e), grid);
#endif
}
```

```cpp
#include <hip/hip_runtime.h>
#include <hip/hip_cooperative_groups.h>
#include <cstdio>
#include <cstdint>
#include <cmath>
namespace cg = cooperative_groups;

#ifndef MK_PER_PHASE
#define MK_PER_PHASE 0
#endif

#ifndef REPEAT_PHASE
#define REPEAT_PHASE 0
#endif
#define NREP(k) ((((REPEAT_PHASE) >> (k)) & 1) ? 2 : 1)
#define LAS __attribute__((address_space(3)))
typedef unsigned short bf16_t;
typedef short bf16x8 __attribute__((ext_vector_type(8)));
typedef short s16x4 __attribute__((ext_vector_type(4)));
typedef float f32x4 __attribute__((ext_vector_type(4)));
typedef float f32x16 __attribute__((ext_vector_type(16)));
typedef unsigned u32x4 __attribute__((ext_vector_type(4)));
typedef unsigned u32x2 __attribute__((ext_vector_type(2)));
typedef float f32x2_t __attribute__((ext_vector_type(2)));
typedef __bf16 bf16x2_t __attribute__((ext_vector_type(2)));

__device__ __forceinline__ unsigned cvtpk(float lo, float hi) { f32x2_t v = {lo, hi}; bf16x2_t b = __builtin_convertvector(v, bf16x2_t); return __builtin_bit_cast(unsigned, b); }
__device__ __forceinline__ float swap32(float v) { auto rr = __builtin_amdgcn_permlane32_swap(__builtin_bit_cast(unsigned, v), __builtin_bit_cast(unsigned, v), false, false); return __builtin_bit_cast(float, (threadIdx.x & 32) ? rr[0] : rr[1]); }
__device__ __forceinline__ float bf2f(unsigned short b) { return __builtin_bit_cast(float, (unsigned)b << 16); }
__device__ __forceinline__ float sigmoidf_(float x) { return __builtin_amdgcn_rcpf(1.0f + __builtin_amdgcn_exp2f(-1.4426950408889634f * x)); }

constexpr int DM = 1024, NB = 16, SEQ = 2048, T = NB * SEQ;
constexpr int HD = 64, NSA_H = 8, NSA_G = 2, MOBA_H = 8;
constexpr int NCMP = 127, NCMP_PAD = 128;
constexpr int DFF = 2816, PLE = 256, IN_COLS = 4888, IN_PAD = 5120;
constexpr float EPS = 1e-6f;
constexpr float C2 = 0.125f * 1.4426950408889634f;

constexpr size_t MiB = 1u << 20;
constexpr size_t WS_CTL = 0;
constexpr size_t WS_WIN = 1 * MiB, WS_WFFI = 11 * MiB, WS_WFFO = 22 * MiB, WS_WOUT = 28 * MiB, WS_WPG = 30 * MiB, WS_WUPN = 32 * MiB, WS_WUPM = 33 * MiB,
                 WS_WPP = 34 * MiB, WS_WCK1 = 35 * MiB, WS_WCV1 = 36 * MiB, WS_WCK2 = 37 * MiB, WS_WCV2 = 37 * MiB + 256 * 1024;
constexpr size_t WS_RSTD0 = 38 * MiB, WS_PBIAS = 38 * MiB + 256 * 1024, WS_B1 = 38 * MiB + 512 * 1024, WS_KMEAN = 39 * MiB, WS_KCC = 40 * MiB, WS_VCC = 41 * MiB,
                 WS_HID = 42 * MiB, WS_ROPE = 46 * MiB, WS_RSSP = 48 * MiB, WS_GN = 50 * MiB, WS_PB = 54 * MiB;
constexpr size_t WS_XB = 72 * MiB;
constexpr size_t WS_YN = 72 * MiB, WS_YM = 104 * MiB;
constexpr size_t WS_QN = 136 * MiB, WS_QM = 168 * MiB, WS_KM = 200 * MiB, WS_VM = 232 * MiB,
                 WS_KC = 264 * MiB, WS_VC = 272 * MiB, WS_KS = 280 * MiB, WS_VS = 288 * MiB, WS_KW = 296 * MiB, WS_VW = 304 * MiB;
constexpr size_t WS_MB = 136 * MiB, WS_HB = 136 * MiB;
constexpr size_t WS_GA = 312 * MiB, WS_GB = 376 * MiB, WS_PP = 440 * MiB, WS_END = 504 * MiB;

namespace pg8 {
constexpr int BM = 256, BK = 64, HALF = 128, HTB = HALF * BK * 2, STAGE_BYTES = 8 * HTB, NXCD = 8, WGM = 8;
__host__ __device__ __forceinline__ int lds_byte(int r, int c) { const int st = (r >> 4) * 2 + (c >> 5), rr = r & 15, cc = c & 31, ob = rr * 64 + cc * 2; return st * 1024 + (ob ^ (((ob >> 9) & 1) << 5)); }
__host__ __device__ __forceinline__ void stage_rc(int b, int& R, int& C) { const int st = b / 1024, sb = b % 1024, swz = sb ^ (((sb >> 9) & 1) << 5); R = (st >> 1) * 16 + swz / 64; C = (st & 1) * 32 + (swz % 64) / 2; }

struct Unit { int pm, pn, aux; const char* A; const char* B; };
struct StaticOrder {
    int nM, nN, nwg, G, c;
    __host__ __device__ void init(int M, int N, int G_, int c_) { nM = M / BM; nN = N / BM; nwg = nM * nN; G = G_; c = c_; }
    __host__ __device__ bool next(int i, int& pm, int& pn) const {
        const long L = (long)i * G + c; if (L >= nwg) return false;
        int wgid = (int)L; { const int q = nwg / NXCD, r = nwg % NXCD, xcd = wgid % NXCD, off = wgid / NXCD; wgid = (xcd < r ? xcd * (q + 1) : r * (q + 1) + (xcd - r) * q) + off; }
        const int nig = WGM * nN, gid = wgid / nig, fm = gid * WGM, gsz = (nM - fm) < WGM ? (nM - fm) : WGM;
        pm = fm + ((wgid % nig) % gsz); pn = (wgid % nig) / gsz; return true;
    }
};

template <class Epi, class Sched>
__device__ __forceinline__ void gemm_phase(LAS unsigned char* lds, const int K_in, const int lda, const int ldb, const Sched& S, const Epi& E) {
    int K = K_in; asm volatile("" : "+s"(K));
    const int tid = threadIdx.x, wid = __builtin_amdgcn_readfirstlane(tid >> 6), lane = tid & 63, wr = wid >> 2, wc = wid & 3, fr = lane & 15, fq = lane >> 4;
    const int nt = K / BK;
    unsigned voffA[2], voffB[2];
#pragma unroll
    for (int i = 0; i < 2; ++i) { int R, C; stage_rc(tid * 16 + i * 8192, R, C); voffA[i] = (unsigned)(R * lda + C) * 2u; voffB[i] = (unsigned)(R * ldb + C) * 2u; }
    const size_t kstep = (size_t)(BK * 2);
    const size_t hstepA = (size_t)HALF * lda * 2, hstepB = (size_t)HALF * ldb * 2;
    const unsigned ldsw = (unsigned)wid * 1024u;
    const int aoff = lds_byte(wr * 64 + fr, fq * 8), boff = lds_byte(wc * 32 + fr, fq * 8);
#define PG8_SA(b, h) (((b) * 2 + (h)) * HTB)
#define PG8_SB(b, h) ((4 + (b) * 2 + (h)) * HTB)
#define PG8_STAGE(bufoff, gbase, voff) do { _Pragma("unroll") for (int _i = 0; _i < 2; ++_i) \
        __builtin_amdgcn_global_load_lds((const unsigned*)((const char*)(gbase) + (voff)[_i]), (LAS unsigned*)(lds + (bufoff) + ldsw + _i * 8192), 16, 0, 0); } while (0)
#define PG8_LDA(dst, b, h) do { _Pragma("unroll") for (int m = 0; m < 4; ++m) _Pragma("unroll") for (int k = 0; k < 2; ++k) dst[m][k] = *(const LAS bf16x8*)(lds + PG8_SA(b, h) + aoff + m * 2048 + k * 1024); } while (0)
#define PG8_LDB(dst, b, h) do { _Pragma("unroll") for (int n = 0; n < 2; ++n) _Pragma("unroll") for (int k = 0; k < 2; ++k) dst[n][k] = *(const LAS bf16x8*)(lds + PG8_SB(b, h) + boff + n * 2048 + k * 1024); } while (0)
#define PG8_MMA(ai, bj, At, Bt) do { __builtin_amdgcn_s_setprio(1); _Pragma("unroll") for (int m = 0; m < 4; ++m) _Pragma("unroll") for (int n = 0; n < 2; ++n) _Pragma("unroll") for (int k = 0; k < 2; ++k) \
        acc[ai][bj][m][n] = __builtin_amdgcn_mfma_f32_16x16x32_bf16(Bt[n][k], At[m][k], acc[ai][bj][m][n], 0, 0, 0); __builtin_amdgcn_s_setprio(0); } while (0)
#define PG8_WAIT_V(n) asm volatile("s_waitcnt vmcnt(" #n ")" ::: "memory")
#define PG8_WAIT_L(n) asm volatile("s_waitcnt lgkmcnt(" #n ")" ::: "memory")
#define PG8_BAR __builtin_amdgcn_s_barrier()
#define PG8_SCHED __builtin_amdgcn_sched_barrier(0)
    Unit cur, nxt; int ui = 0;
    if (!S.next(0, cur)) return;
    f32x4 acc[2][2][4][2];
#pragma unroll
    for (int a = 0; a < 2; ++a)
#pragma unroll
        for (int b = 0; b < 2; ++b)
#pragma unroll
            for (int m = 0; m < 4; ++m)
#pragma unroll
                for (int n = 0; n < 2; ++n) acc[a][b][m][n] = (f32x4){0.f, 0.f, 0.f, 0.f};
    bf16x8 At[4][2], B0[2][2], B1[2][2];
    const char* cA = cur.A; const char* cB = cur.B;
    PG8_STAGE(PG8_SB(0, 0), cB, voffB); PG8_STAGE(PG8_SB(0, 1), cB + hstepB, voffB); PG8_STAGE(PG8_SA(0, 0), cA, voffA); PG8_STAGE(PG8_SA(0, 1), cA + hstepA, voffA);
    if (wr == 1) PG8_BAR;
    PG8_WAIT_V(2); PG8_BAR;
    PG8_STAGE(PG8_SB(1, 0), cB + kstep, voffB); PG8_STAGE(PG8_SA(1, 0), cA + kstep, voffA); PG8_STAGE(PG8_SB(1, 1), cB + hstepB + kstep, voffB);
    PG8_WAIT_V(6); PG8_BAR;
    for (;;) {
        const bool has_next = S.next(ui + 1, nxt);
        const char* nA = has_next ? nxt.A : cA; const char* nB = has_next ? nxt.B : cB;
        for (int t = 0; t < nt; t += 2) {
            const bool last = (t == nt - 2);
            const char* a1 = cA + (size_t)(t + 1) * kstep;
            const char* a2 = last ? nA : cA + (size_t)(t + 2) * kstep; const char* b2 = last ? nB : cB + (size_t)(t + 2) * kstep;
            const char* a3 = a2 + kstep; const char* b3 = b2 + kstep;
            PG8_LDB(B0, 0, 0); PG8_LDB(B1, 0, 1); PG8_SCHED; PG8_LDA(At, 0, 0); PG8_STAGE(PG8_SA(1, 1), a1 + hstepA, voffA);
            PG8_WAIT_V(8); PG8_WAIT_L(0); PG8_BAR; PG8_MMA(0, 0, At, B0); PG8_MMA(0, 1, At, B1); PG8_BAR; PG8_SCHED;
            PG8_LDA(At, 0, 1); PG8_STAGE(PG8_SB(0, 0), b2, voffB); PG8_STAGE(PG8_SB(0, 1), b2 + hstepB, voffB); PG8_STAGE(PG8_SA(0, 0), a2, voffA);
            PG8_WAIT_V(8); PG8_WAIT_L(0); PG8_BAR; PG8_MMA(1, 0, At, B0); PG8_MMA(1, 1, At, B1); PG8_BAR; PG8_SCHED;
            PG8_LDB(B0, 1, 0); PG8_LDB(B1, 1, 1); PG8_SCHED; PG8_LDA(At, 1, 0); PG8_STAGE(PG8_SA(0, 1), a2 + hstepA, voffA);
            PG8_WAIT_V(8); PG8_WAIT_L(0); PG8_BAR; PG8_MMA(0, 0, At, B0); PG8_MMA(0, 1, At, B1); PG8_BAR; PG8_SCHED;
            PG8_LDA(At, 1, 1); PG8_STAGE(PG8_SB(1, 0), b3, voffB); PG8_STAGE(PG8_SB(1, 1), b3 + hstepB, voffB); PG8_STAGE(PG8_SA(1, 0), a3, voffA);
            PG8_WAIT_V(8); PG8_WAIT_L(0); PG8_BAR; PG8_MMA(1, 0, At, B0); PG8_MMA(1, 1, At, B1); PG8_BAR; PG8_SCHED;
        }
        if (wr == 0) PG8_BAR;
        E(acc, cur, wr, wc, fr, fq);
        if (!has_next) break;
#pragma unroll
        for (int a = 0; a < 2; ++a)
#pragma unroll
            for (int b = 0; b < 2; ++b)
#pragma unroll
                for (int m = 0; m < 4; ++m)
#pragma unroll
                    for (int n = 0; n < 2; ++n) acc[a][b][m][n] = (f32x4){0.f, 0.f, 0.f, 0.f};
        cur = nxt; cA = nA; cB = nB; ++ui;
        if (wr == 1) PG8_BAR;
    }
    PG8_WAIT_V(0);
    PG8_BAR;
#undef PG8_SA
#undef PG8_SB
#undef PG8_STAGE
#undef PG8_LDA
#undef PG8_LDB
#undef PG8_MMA
#undef PG8_WAIT_V
#undef PG8_WAIT_L
#undef PG8_BAR
#undef PG8_SCHED
}
}
using pg8::Unit;
typedef f32x4 Acc[2][2][4][2];

__host__ __device__ __forceinline__ int phys_col(int L) { const int tile = L >> 8, l = L & 255, wc = l >> 6, fq = (l >> 4) & 3, bj = (l >> 3) & 1, n = (l >> 2) & 1, i = l & 3; return tile * 256 + 128 * bj + 32 * wc + 16 * n + 4 * fq + i; }

struct SchedStd {
    pg8::StaticOrder so; const char* A; const char* B; size_t a_tile, b_tile; int nmine, reps;
    __device__ __forceinline__ void init(const void* A_, int lda, const void* B_, int ldb, int M, int N, int reps_ = 1) { so.init(M, N, (int)gridDim.x, (int)blockIdx.x); A = (const char*)A_; B = (const char*)B_; a_tile = (size_t)256 * lda * 2; b_tile = (size_t)256 * ldb * 2;
        nmine = so.nwg > so.c ? (so.nwg - so.c + so.G - 1) / so.G : 0; reps = reps_; }
    __device__ __forceinline__ bool next(int i, Unit& u) const { int pm, pn; if (i >= nmine * reps) return false; so.next(i % nmine, pm, pn); u.pm = pm; u.pn = pn; u.aux = 0; u.A = A + (size_t)pm * a_tile; u.B = B + (size_t)pn * b_tile; return true; }
};
struct SchedMerge {
    pg8::StaticOrder so; const char* A0; const char* A1; const char* B0; const char* B1; size_t a_tile, b_tile; int nmine;
    __device__ __forceinline__ void init(const void* A0_, const void* A1_, const void* B0_, const void* B1_, int ld, int M, int N) { so.init(M, N, (int)gridDim.x, (int)blockIdx.x);
        A0 = (const char*)A0_; A1 = (const char*)A1_; B0 = (const char*)B0_; B1 = (const char*)B1_; a_tile = (size_t)256 * ld * 2; b_tile = (size_t)256 * ld * 2;
        nmine = so.nwg > so.c ? (so.nwg - so.c + so.G - 1) / so.G : 0; }
    __device__ __forceinline__ bool next(int i, Unit& u) const { int pm, pn; if (i >= 2 * nmine) return false; so.next(i >> 1, pm, pn); u.pm = pm; u.pn = pn; u.aux = i & 1;
        u.A = ((i & 1) ? A1 : A0) + (size_t)pm * a_tile; u.B = ((i & 1) ? B1 : B0) + (size_t)pn * b_tile; return true; }
};
struct SchedCmp {
    const char* A0; const char* A1; const char* B0; const char* B1; size_t a_tile;
    __device__ __forceinline__ bool next(int i, Unit& u) const { const int c = (int)blockIdx.x; if (i >= NREP(2) || c >= 32) return false; u.aux = c >> 4; u.pm = c & 15; u.pn = 0; u.A = (u.aux ? A1 : A0) + (size_t)u.pm * a_tile; u.B = u.aux ? B1 : B0; return true; }
};

#define EPI_ROWS_BEGIN _Pragma("unroll") for (int ai = 0; ai < 2; ++ai) _Pragma("unroll") for (int m = 0; m < 4; ++m) { const int row = u.pm * 256 + ai * 128 + wr * 64 + m * 16 + fr; float v[16]; \
    _Pragma("unroll") for (int bj = 0; bj < 2; ++bj) _Pragma("unroll") for (int n = 0; n < 2; ++n) _Pragma("unroll") for (int i = 0; i < 4; ++i) v[8 * bj + 4 * n + i] = acc[ai][bj][m][n][i];
#define EPI_ROWS_END }
__device__ __forceinline__ void store_bf16x16(bf16_t* dst, const float (&v)[16]) {
    u32x4 a, b; a.x = cvtpk(v[0], v[1]); a.y = cvtpk(v[2], v[3]); a.z = cvtpk(v[4], v[5]); a.w = cvtpk(v[6], v[7]);
    b.x = cvtpk(v[8], v[9]); b.y = cvtpk(v[10], v[11]); b.z = cvtpk(v[12], v[13]); b.w = cvtpk(v[14], v[15]);
    *(u32x4*)dst = a; *(u32x4*)(dst + 8) = b;
}
__device__ __forceinline__ float rstd_from_parts(const float* rssp, int row) {
    const f32x4* p = (const f32x4*)(rssp + (size_t)row * 16); const f32x4 a = p[0], b = p[1], c = p[2], d = p[3];
    const float s = ((a.x + a.y) + (a.z + a.w)) + ((b.x + b.y) + (b.z + b.w)) + ((c.x + c.y) + (c.z + c.w)) + ((d.x + d.y) + (d.z + d.w));
    return rsqrtf(s * (1.0f / DM) + EPS);
}

struct EpiProj {
    const float* rstd0; const float* rope; const float* gq; const float* gks; const float* gkw; const float* gmq; const float* gmk;
    bf16_t *QN, *KC, *VC, *KS, *VS, *KW, *VW, *QM, *KM, *VM, *GA, *GB; float* GN;
    __device__ __forceinline__ void operator()(const Acc& acc, const Unit& u, int wr, int wc, int fr, int fq) const {
        const int slot = u.pn * 4 + wc;
        int kind; bf16_t* base; const float* gain = nullptr; int nh = 1, hh = 0; bool ropeq = false; float sc = 1.f;
        if (slot < 8) { kind = 0; base = QN; gain = gq; nh = 8; hh = slot; ropeq = true; sc = C2; }
        else if (slot < 20) { const int s2 = slot - 8, which = s2 >> 1; kind = 0; nh = 2; hh = s2 & 1;
            base = which == 0 ? KC : which == 1 ? VC : which == 2 ? KS : which == 3 ? VS : which == 4 ? KW : VW;
            if (which == 2) { gain = gks; ropeq = true; } else if (which == 4) { gain = gkw; ropeq = true; } }
        else if (slot < 28) { kind = 0; base = QM; gain = gmq; nh = 8; hh = slot - 20; ropeq = true; sc = C2; }
        else if (slot < 36) { kind = 0; base = KM; gain = gmk; nh = 8; hh = slot - 28; ropeq = true; }
        else if (slot < 44) { kind = 0; base = VM; nh = 8; hh = slot - 36; }
        else if (slot < 60) { kind = 1; base = (bf16_t*)((unsigned char*)GA + (slot - 44) * 64); }
        else if (slot < 76) { kind = 1; base = (bf16_t*)((unsigned char*)GB + (slot - 60) * 64); }
        else if (slot == 76) { kind = 2; base = nullptr; }
        else return;
        float g16[16];
        if (gain) {
#pragma unroll
            for (int c = 0; c < 16; ++c) g16[c] = gain[16 * fq + c] * sc;
        }
        EPI_ROWS_BEGIN
            const float rs = rstd0[row];
            if (kind == 0) {
                if (gain) {
                    float ss = 0.f;
#pragma unroll
                    for (int c = 0; c < 16; ++c) ss += v[c] * v[c];
                    ss += __shfl_xor(ss, 16); ss += __shfl_xor(ss, 32);
                    const float f = rs * rsqrtf(rs * rs * ss * (1.0f / 64.0f) + EPS);
#pragma unroll
                    for (int c = 0; c < 16; ++c) v[c] = v[c] * f * g16[c];
                } else {
#pragma unroll
                    for (int c = 0; c < 16; ++c) v[c] *= rs;
                }
                if (ropeq && fq == 0) {
                    const f32x4* rp = (const f32x4*)(rope + (size_t)row * 16); const f32x4 c0 = rp[0], c1 = rp[1], s0 = rp[2], s1 = rp[3];
                    const float cs[8] = {c0.x, c0.y, c0.z, c0.w, c1.x, c1.y, c1.z, c1.w}, sn[8] = {s0.x, s0.y, s0.z, s0.w, s1.x, s1.y, s1.z, s1.w};
#pragma unroll
                    for (int j = 0; j < 8; ++j) { const float a = v[j], b = v[j + 8]; v[j] = a * cs[j] - b * sn[j]; v[j + 8] = b * cs[j] + a * sn[j]; }
                }
                const int b = row >> 11, t = row & (SEQ - 1);
                store_bf16x16(base + ((size_t)(b * nh + hh) * SEQ + t) * 64 + 16 * fq, v);
            } else if (kind == 1) {
                const float kexp = -1.4426950408889634f * rs;
                unsigned w[4];
#pragma unroll
                for (int c4 = 0; c4 < 4; ++c4) { unsigned pk = 0u;
#pragma unroll
                    for (int i = 0; i < 4; ++i) { const float e = __builtin_amdgcn_exp2f(v[4 * c4 + i] * kexp);
                        pk = __builtin_amdgcn_cvt_pk_u8_f32(__builtin_amdgcn_rcpf(__builtin_fmaf(e, 1.0f / 255.0f, 1.0f / 255.0f)), i, pk); }
                    w[c4] = pk; }
                *(u32x4*)((unsigned char*)base + (size_t)row * DM + 16 * fq) = (u32x4){w[0], w[1], w[2], w[3]};
            } else {
                if (fq < 2) {
#pragma unroll
                    for (int c = 0; c < 16; ++c) v[c] = sigmoidf_(v[c] * rs);
                    f32x4* d = (f32x4*)(GN + (size_t)row * 32 + 16 * fq);
                    d[0] = (f32x4){v[0], v[1], v[2], v[3]}; d[1] = (f32x4){v[4], v[5], v[6], v[7]};
                    if (fq == 0) { d[2] = (f32x4){v[8], v[9], v[10], v[11]}; d[3] = (f32x4){v[12], v[13], v[14], v[15]}; }
                }
            }
        EPI_ROWS_END
    }
};
struct EpiCmp1 {
    const float* b1; bf16_t* hid;
    __device__ __forceinline__ void operator()(const Acc& acc, const Unit& u, int wr, int wc, int fr, int fq) const {
        float bb[16];
#pragma unroll
        for (int c = 0; c < 16; ++c) bb[c] = b1[u.aux * 256 + 64 * wc + 16 * fq + c];
        bf16_t* H = hid + (size_t)u.aux * 4096 * 256;
        EPI_ROWS_BEGIN
#pragma unroll
            for (int c = 0; c < 16; ++c) { const float x = v[c] + bb[c]; v[c] = x * sigmoidf_(x); }
            store_bf16x16(H + (size_t)row * 256 + 64 * wc + 16 * fq, v);
        EPI_ROWS_END
    }
};
struct EpiCmp2 {
    const float* gkc; const float* rope; bf16_t* KCC; bf16_t* VCC;
    __device__ __forceinline__ void operator()(const Acc& acc, const Unit& u, int wr, int wc, int fr, int fq) const {
        if (wc != 0) return;
        float g16[16];
#pragma unroll
        for (int c = 0; c < 16; ++c) g16[c] = gkc[16 * fq + c];
        EPI_ROWS_BEGIN
            const int bg = row >> 7, c_ = row & 127, b = bg >> 1;
            if (u.aux == 0) {
                float ss = 0.f;
#pragma unroll
                for (int c = 0; c < 16; ++c) ss += v[c] * v[c];
                ss += __shfl_xor(ss, 16); ss += __shfl_xor(ss, 32);
                const float rn = rsqrtf(ss * (1.0f / 64.0f) + EPS);
#pragma unroll
                for (int c = 0; c < 16; ++c) v[c] = v[c] * rn * g16[c];
                if (fq == 0) {
                    int tp = c_ * 16 + 31; if (tp > SEQ - 1) tp = SEQ - 1;
                    const f32x4* rp = (const f32x4*)(rope + ((size_t)b * SEQ + tp) * 16); const f32x4 c0 = rp[0], c1 = rp[1], s0 = rp[2], s1 = rp[3];
                    const float cs[8] = {c0.x, c0.y, c0.z, c0.w, c1.x, c1.y, c1.z, c1.w}, sn[8] = {s0.x, s0.y, s0.z, s0.w, s1.x, s1.y, s1.z, s1.w};
#pragma unroll
                    for (int j = 0; j < 8; ++j) { const float a = v[j], bq = v[j + 8]; v[j] = a * cs[j] - bq * sn[j]; v[j + 8] = bq * cs[j] + a * sn[j]; }
                }
                store_bf16x16(KCC + (size_t)row * 64 + 16 * fq, v);
            } else {
                store_bf16x16(VCC + (size_t)row * 64 + 16 * fq, v);
            }
        EPI_ROWS_END
    }
};
struct EpiMerge {
    const bf16_t* GA; const bf16_t* GB; bf16_t* MB;
    __device__ __forceinline__ void operator()(const Acc& acc, const Unit& u, int wr, int wc, int fr, int fq) const {
        const int col = u.pn * 256 + 64 * wc + 16 * fq;
        const unsigned char* G = (const unsigned char*)(u.aux ? GB : GA);
        EPI_ROWS_BEGIN
            const u32x4 g0 = *(const u32x4*)(G + (size_t)row * DM + col);
            const unsigned gw[4] = {g0.x, g0.y, g0.z, g0.w};
#pragma unroll
            for (int c = 0; c < 16; ++c) v[c] *= (float)((gw[c >> 2] >> (8 * (c & 3))) & 255u) * (1.0f / 255.0f);
            bf16_t* mp = MB + (size_t)row * DM + col;
            if (u.aux) {
                const u32x4 m0 = ((const u32x4*)mp)[0], m1 = ((const u32x4*)mp)[1];
                const unsigned mw[8] = {m0.x, m0.y, m0.z, m0.w, m1.x, m1.y, m1.z, m1.w};
#pragma unroll
                for (int c = 0; c < 8; ++c) { v[2 * c] += __builtin_bit_cast(float, mw[c] << 16); v[2 * c + 1] += __builtin_bit_cast(float, mw[c] & 0xffff0000u); }
            }
            store_bf16x16(mp, v);
        EPI_ROWS_END
    }
};
template <bool XF32> struct EpiResid {
    const float* xi; bf16_t* xb; float* rssp;
    __device__ __forceinline__ void operator()(const Acc& acc, const Unit& u, int wr, int wc, int fr, int fq) const {
        const int col = u.pn * 256 + 64 * wc + 16 * fq;
        EPI_ROWS_BEGIN
            bf16_t* bp = xb + (size_t)row * DM + col;
            if (XF32) { const f32x4* ip = (const f32x4*)(xi + (size_t)row * DM + col);
#pragma unroll
                for (int q = 0; q < 4; ++q) { const f32x4 x = ip[q]; v[4 * q] += x.x; v[4 * q + 1] += x.y; v[4 * q + 2] += x.z; v[4 * q + 3] += x.w; } }
            else { const u32x4 m0 = ((const u32x4*)bp)[0], m1 = ((const u32x4*)bp)[1]; const unsigned mw[8] = {m0.x, m0.y, m0.z, m0.w, m1.x, m1.y, m1.z, m1.w};
#pragma unroll
                for (int c = 0; c < 8; ++c) { v[2 * c] += __builtin_bit_cast(float, mw[c] << 16); v[2 * c + 1] += __builtin_bit_cast(float, mw[c] & 0xffff0000u); } }
            float ss = 0.f;
#pragma unroll
            for (int c = 0; c < 16; ++c) ss += v[c] * v[c];
            store_bf16x16(bp, v);
            ss += __shfl_xor(ss, 16); ss += __shfl_xor(ss, 32);
            if (fq == 0) rssp[(size_t)row * 16 + u.pn * 4 + wc] = ss;
        EPI_ROWS_END
    }
};
struct EpiFfnIn {
    const float* rssp; bf16_t* HB;
    __device__ __forceinline__ void operator()(const Acc& acc, const Unit& u, int wr, int wc, int fr, int fq) const {
        const int hcol = u.pn * 128 + 32 * wc + 8 * fq;
        EPI_ROWS_BEGIN
            const float rs = rstd_from_parts(rssp, row);
            float h[8];
            const float kexp = -1.4426950408889634f * rs, irs2 = __builtin_amdgcn_rcpf(rs * rs);
#pragma unroll
            for (int c = 0; c < 8; ++c) { const float e = __builtin_amdgcn_exp2f(v[c] * kexp); h[c] = (v[c] * v[c + 8]) * __builtin_amdgcn_rcpf(__builtin_fmaf(e, irs2, irs2)); }
            u32x4 w; w.x = cvtpk(h[0], h[1]); w.y = cvtpk(h[2], h[3]); w.z = cvtpk(h[4], h[5]); w.w = cvtpk(h[6], h[7]);
            *(u32x4*)(HB + (size_t)row * DFF + hcol) = w;
        EPI_ROWS_END
    }
};
struct EpiStoreBf16 {
    bf16_t* PP;
    __device__ __forceinline__ void operator()(const Acc& acc, const Unit& u, int wr, int wc, int fr, int fq) const {
        const int col = u.pn * 256 + 64 * wc + 16 * fq;
        EPI_ROWS_BEGIN
            store_bf16x16(PP + (size_t)row * DM + col, v);
        EPI_ROWS_END
    }
};
struct EpiPle {
    const float* rssp; const bf16_t* PP; const bf16_t* xb; float* out;
    __device__ __forceinline__ void operator()(const Acc& acc, const Unit& u, int wr, int wc, int fr, int fq) const {
        const int col = u.pn * 256 + 64 * wc + 16 * fq;
        EPI_ROWS_BEGIN
            const float rs = rstd_from_parts(rssp, row); const float kexp = -1.4426950408889634f * rs;
            const u32x4* pp = (const u32x4*)(PP + (size_t)row * DM + col); const u32x4* xp = (const u32x4*)(xb + (size_t)row * DM + col);
            const u32x4 p0 = pp[0], p1 = pp[1], x0 = xp[0], x1 = xp[1];
            const unsigned pw[8] = {p0.x, p0.y, p0.z, p0.w, p1.x, p1.y, p1.z, p1.w}, xw[8] = {x0.x, x0.y, x0.z, x0.w, x1.x, x1.y, x1.z, x1.w};
#pragma unroll
            for (int c = 0; c < 8; ++c) {
                v[2 * c] = __builtin_fmaf(__builtin_amdgcn_rcpf(1.0f + __builtin_amdgcn_exp2f(v[2 * c] * kexp)), __builtin_bit_cast(float, pw[c] << 16), __builtin_bit_cast(float, xw[c] << 16));
                v[2 * c + 1] = __builtin_fmaf(__builtin_amdgcn_rcpf(1.0f + __builtin_amdgcn_exp2f(v[2 * c + 1] * kexp)), __builtin_bit_cast(float, pw[c] & 0xffff0000u), __builtin_bit_cast(float, xw[c] & 0xffff0000u)); }
            f32x4* op = (f32x4*)(out + (size_t)row * DM + col);
#pragma unroll
            for (int q = 0; q < 4; ++q) op[q] = (f32x4){v[4 * q], v[4 * q + 1], v[4 * q + 2], v[4 * q + 3]};
        EPI_ROWS_END
    }
};

struct Args {
    const float* in[26]; const int* pos; float* out; unsigned char* ws;
    float inv_freq[8];
    int ph_lo, ph_hi;
};

__device__ __forceinline__ float wave_sum(float v) {
#pragma unroll
    for (int o = 1; o < 64; o <<= 1) v += __shfl_xor(v, o);
    return v;
}
__device__ __forceinline__ int srccol_win(int L) { if (L < 1280) return L; if (L < 4864) return L + 24; if (L < 4888) return 1280 + (L - 4864); return -1; }
__device__ __forceinline__ int srccol_ffi(int L) { const int tile = L >> 8, l = L & 255, wq = l >> 4, jj = l & 15; const int hid = tile * 128 + wq * 8 + (jj & 7); return (jj < 8 ? 0 : DFF) + hid; }
template <int MAP>
__device__ __forceinline__ void transpose_item(const float* W, int K, int ldw, int nvalid, const float* gain, bf16_t* WT, LAS float* scr, int item, int nblk, int lane) {
    const int kb = item / nblk, nb = item % nblk, k0 = 32 * kb, n0 = 64 * nb;
    const int L = n0 + lane; const int sc = MAP == 1 ? srccol_win(L) : MAP == 2 ? srccol_ffi(L) : (L < nvalid ? L : -1);
    float xv[32];
#pragma unroll
    for (int i = 0; i < 32; ++i) xv[i] = sc >= 0 ? __builtin_nontemporal_load(W + (size_t)(k0 + i) * ldw + sc) : 0.f;
#pragma unroll
    for (int i = 0; i < 32; ++i) { float x = xv[i]; if (gain) x *= gain[k0 + i]; scr[i * 65 + lane] = x; }
    asm volatile("s_waitcnt lgkmcnt(0)" ::: "memory");
    const int ch = lane & 3;
#pragma unroll
    for (int j = 0; j < 4; ++j) { const int nn = (lane >> 2) + 16 * j; const LAS float* s = scr + (8 * ch) * 65 + nn;
        u32x4 o; o.x = cvtpk(s[0], s[65]); o.y = cvtpk(s[2 * 65], s[3 * 65]); o.z = cvtpk(s[4 * 65], s[5 * 65]); o.w = cvtpk(s[6 * 65], s[7 * 65]);
        *(u32x4*)(WT + (size_t)phys_col(n0 + nn) * K + k0 + 8 * ch) = o; }
    asm volatile("s_waitcnt lgkmcnt(0)" ::: "memory");
}

__device__ __forceinline__ void p0_prologue(const Args& a, LAS unsigned char* lds, int tid, int lane, int wave) {
    unsigned char* ws = a.ws;
    LAS float* scr = (LAS float*)(lds + wave * 16384);
    const int gw = (int)blockIdx.x * 8 + wave, NGW = (int)gridDim.x * 8;
    constexpr int I_WIN = 32 * 80, I_UP = 16 * 16, I_OUT = 32 * 16, I_FFI = 32 * 88, I_FFO = 88 * 16, I_PG = 32 * 16, I_PP = 8 * 16, I_C1 = 64 * 4, I_C2 = 8 * 4;
    constexpr int NIT = I_WIN + 2 * I_UP + I_OUT + I_FFI + I_FFO + I_PG + I_PP + 2 * I_C1 + 2 * I_C2;
    for (int it0 = gw; it0 < NIT * NREP(0); it0 += NGW) {
        int r = it0 % NIT;
        if (r < I_WIN) { transpose_item<1>(a.in[4], 1024, IN_COLS, 0, a.in[3], (bf16_t*)(ws + WS_WIN), scr, r, 80, lane); continue; } r -= I_WIN;
        if (r < I_FFI) { transpose_item<2>(a.in[21], 1024, 2 * DFF, 0, a.in[20], (bf16_t*)(ws + WS_WFFI), scr, r, 88, lane); continue; } r -= I_FFI;
        if (r < I_FFO) { transpose_item<0>(a.in[22], DFF, 1024, 1024, nullptr, (bf16_t*)(ws + WS_WFFO), scr, r, 16, lane); continue; } r -= I_FFO;
        if (r < I_OUT) { transpose_item<0>(a.in[19], 1024, 1024, 1024, nullptr, (bf16_t*)(ws + WS_WOUT), scr, r, 16, lane); continue; } r -= I_OUT;
        if (r < I_PG) { transpose_item<0>(a.in[24], 1024, 1024, 1024, a.in[23], (bf16_t*)(ws + WS_WPG), scr, r, 16, lane); continue; } r -= I_PG;
        if (r < I_UP) { transpose_item<0>(a.in[17], 512, 1024, 1024, nullptr, (bf16_t*)(ws + WS_WUPN), scr, r, 16, lane); continue; } r -= I_UP;
        if (r < I_UP) { transpose_item<0>(a.in[18], 512, 1024, 1024, nullptr, (bf16_t*)(ws + WS_WUPM), scr, r, 16, lane); continue; } r -= I_UP;
        if (r < I_PP) { transpose_item<0>(a.in[25], 256, 1024, 1024, nullptr, (bf16_t*)(ws + WS_WPP), scr, r, 16, lane); continue; } r -= I_PP;
        if (r < I_C1) { transpose_item<0>(a.in[11], 2048, 256, 256, nullptr, (bf16_t*)(ws + WS_WCK1), scr, r, 4, lane); continue; } r -= I_C1;
        if (r < I_C1) { transpose_item<0>(a.in[13], 2048, 256, 256, nullptr, (bf16_t*)(ws + WS_WCV1), scr, r, 4, lane); continue; } r -= I_C1;
        if (r < I_C2) { transpose_item<0>(a.in[12], 256, 64, 64, nullptr, (bf16_t*)(ws + WS_WCK2), scr, r, 4, lane); continue; } r -= I_C2;
        transpose_item<0>(a.in[14], 256, 64, 64, nullptr, (bf16_t*)(ws + WS_WCV2), scr, r, 4, lane);
    }
    {
        const float* x = a.in[0]; bf16_t* XB = (bf16_t*)(ws + WS_XB); float* rstd0 = (float*)(ws + WS_RSTD0);
        const float* p = a.in[1]; bf16_t* PB = (bf16_t*)(ws + WS_PB);
        for (int m0 = gw; m0 < T * NREP(0); m0 += NGW) { const int m = m0 % T;
            const f32x4* xr = (const f32x4*)(x + (size_t)m * DM) + lane; f32x4 v[4]; float s = 0.f;
#pragma unroll
            for (int j = 0; j < 4; ++j) { v[j] = __builtin_nontemporal_load(xr + 64 * j); s += (v[j].x * v[j].x + v[j].y * v[j].y) + (v[j].z * v[j].z + v[j].w * v[j].w); }
            const f32x4 pv = __builtin_nontemporal_load((const f32x4*)(p + (size_t)m * PLE) + lane);
            s = wave_sum(s);
            if (lane == 0) rstd0[m] = rsqrtf(s * (1.0f / DM) + EPS);
            u32x2* o8 = (u32x2*)(XB + (size_t)m * DM) + lane;
#pragma unroll
            for (int j = 0; j < 4; ++j) o8[64 * j] = (u32x2){cvtpk(v[j].x, v[j].y), cvtpk(v[j].z, v[j].w)};
            ((u32x2*)(PB + (size_t)m * PLE))[lane] = (u32x2){cvtpk(pv.x, pv.y), cvtpk(pv.z, pv.w)};
        }
    }
    {
        float* rope = (float*)(ws + WS_ROPE); const int gt = (int)blockIdx.x * 512 + tid, NGT = (int)gridDim.x * 512;
        const float f0 = a.inv_freq[0], f1 = a.inv_freq[1], f2 = a.inv_freq[2], f3 = a.inv_freq[3], f4 = a.inv_freq[4], f5 = a.inv_freq[5], f6 = a.inv_freq[6], f7 = a.inv_freq[7];
        for (int row0 = gt; row0 < T * NREP(0); row0 += NGT) { const int row = row0 % T; const float pf = (float)a.pos[row]; const float fr8[8] = {f0, f1, f2, f3, f4, f5, f6, f7}; float cs[8], sn[8];
#pragma unroll
            for (int j = 0; j < 8; ++j) { const float ang = pf * fr8[j]; double rev = (double)ang * 0.15915494309189535; rev -= floor(rev); const float fr = (float)rev;
                cs[j] = __builtin_amdgcn_cosf(fr); sn[j] = __builtin_amdgcn_sinf(fr); }
            f32x4* o = (f32x4*)(rope + (size_t)row * 16);
            o[0] = (f32x4){cs[0], cs[1], cs[2], cs[3]}; o[1] = (f32x4){cs[4], cs[5], cs[6], cs[7]}; o[2] = (f32x4){sn[0], sn[1], sn[2], sn[3]}; o[3] = (f32x4){sn[4], sn[5], sn[6], sn[7]}; }
    }
    {
        float* pb = (float*)(ws + WS_PBIAS);
        for (int it = gw; it < 64; it += NGW) { const int kv = it >> 5, kc = it & 31; const float* pe = kv ? a.in[10] : a.in[9]; const float* w1 = kv ? a.in[13] : a.in[11];
            float s0 = 0.f, s1 = 0.f, s2 = 0.f, s3 = 0.f;
            for (int kk = 0; kk < 64; ++kk) { const int k = kc * 64 + kk; const float pv = pe[k]; const float* wr = w1 + (size_t)k * 256 + lane;
                s0 += pv * wr[0]; s1 += pv * wr[64]; s2 += pv * wr[128]; s3 += pv * wr[192]; }
            float* o = pb + (size_t)(kv * 32 + kc) * 256 + lane; o[0] = s0; o[64] = s1; o[128] = s2; o[192] = s3; }
    }
}

__device__ __forceinline__ void kmean_phase(const Args& a, int lane, int wave) {
    const bf16_t* KM = (const bf16_t*)(a.ws + WS_KM); float* KMEAN = (float*)(a.ws + WS_KMEAN);
    const int gw = (int)blockIdx.x * 8 + wave, NGW = (int)gridDim.x * 8;
    for (int it0 = gw; it0 < NB * MOBA_H * 8 * NREP(2); it0 += NGW) { const int it = it0 % (NB * MOBA_H * 8);
        const u32x4* src = (const u32x4*)(KM + (size_t)it * 256 * 64) + lane; float s[8];
#pragma unroll
        for (int c = 0; c < 8; ++c) s[c] = 0.f;
#pragma unroll 8
        for (int i = 0; i < 32; ++i) { const u32x4 w = src[64 * i]; const unsigned ww[4] = {w.x, w.y, w.z, w.w};
#pragma unroll
            for (int c = 0; c < 4; ++c) { s[2 * c] += __builtin_bit_cast(float, ww[c] << 16); s[2 * c + 1] += __builtin_bit_cast(float, ww[c] & 0xffff0000u); } }
#pragma unroll
        for (int c = 0; c < 8; ++c) { s[c] += __shfl_xor(s[c], 8); s[c] += __shfl_xor(s[c], 16); s[c] += __shfl_xor(s[c], 32); }
        if (lane < 8) { f32x4* o = (f32x4*)(KMEAN + (size_t)it * 64 + lane * 8);
            o[0] = (f32x4){s[0], s[1], s[2], s[3]} * (1.0f / 256.0f); o[1] = (f32x4){s[4], s[5], s[6], s[7]} * (1.0f / 256.0f); }
    }
}

constexpr int KROW = 144, VROW = 192;
constexpr int L_K = 0, L_V = 2 * 64 * KROW, L_IMP = L_V + 2 * 64 * VROW, L_SEL = L_IMP + 4 * 64 * 33 * 4, L_KMEAN = L_SEL + 256, L_Q = L_KMEAN + 2048, L_Y = L_Q + 64, L_ATT_END = L_Y + 65536;
static_assert(L_ATT_END <= 147456, "attention LDS");
struct AttnState { float m, l; f32x16 o[2]; f32x16 negm; };
__device__ __forceinline__ void attn_reset(AttnState& st) { st.m = 0.f; st.l = 0.f;
#pragma unroll
    for (int r = 0; r < 16; ++r) { st.o[0][r] = 0.f; st.o[1][r] = 0.f; st.negm[r] = 0.f; } }
__device__ __forceinline__ s16x4 vtr(const LAS unsigned char* p) { return __builtin_bit_cast(s16x4, __builtin_amdgcn_ds_read_tr16_b64_v4i16((LAS s16x4*)p)); }
__device__ __forceinline__ void pv_subtile(AttnState& st, const LAS unsigned char* vb, const f32x16& p) {
    u32x4 w0, w1; w0.x = cvtpk(p[0], p[1]); w0.y = cvtpk(p[2], p[3]); w0.z = cvtpk(p[4], p[5]); w0.w = cvtpk(p[6], p[7]);
    w1.x = cvtpk(p[8], p[9]); w1.y = cvtpk(p[10], p[11]); w1.z = cvtpk(p[12], p[13]); w1.w = cvtpk(p[14], p[15]);
    const bf16x8 pf0 = __builtin_bit_cast(bf16x8, w0), pf1 = __builtin_bit_cast(bf16x8, w1);
#pragma unroll
    for (int dh = 0; dh < 2; ++dh) {
        const s16x4 a0 = vtr(vb + dh * 64), a1 = vtr(vb + dh * 64 + 8 * VROW), b0 = vtr(vb + dh * 64 + 16 * VROW), b1 = vtr(vb + dh * 64 + 24 * VROW);
        const bf16x8 vf0 = {a0[0], a0[1], a0[2], a0[3], a1[0], a1[1], a1[2], a1[3]}, vf1 = {b0[0], b0[1], b0[2], b0[3], b1[0], b1[1], b1[2], b1[3]};
        st.o[dh] = __builtin_amdgcn_mfma_f32_32x32x16_bf16(vf0, pf0, st.o[dh], 0, 0, 0);
        st.o[dh] = __builtin_amdgcn_mfma_f32_32x32x16_bf16(vf1, pf1, st.o[dh], 0, 0, 0);
    }
}
struct VFrags { s16x4 f[2][4]; };
__device__ __forceinline__ VFrags v_preload(const LAS unsigned char* vb) { VFrags v;
#pragma unroll
    for (int dh = 0; dh < 2; ++dh) { v.f[dh][0] = vtr(vb + dh * 64); v.f[dh][1] = vtr(vb + dh * 64 + 8 * VROW); v.f[dh][2] = vtr(vb + dh * 64 + 16 * VROW); v.f[dh][3] = vtr(vb + dh * 64 + 24 * VROW); }
    return v; }
__device__ __forceinline__ void pv_subtile_pre(AttnState& st, const VFrags& v, const f32x16& p) {
    u32x4 w0, w1; w0.x = cvtpk(p[0], p[1]); w0.y = cvtpk(p[2], p[3]); w0.z = cvtpk(p[4], p[5]); w0.w = cvtpk(p[6], p[7]);
    w1.x = cvtpk(p[8], p[9]); w1.y = cvtpk(p[10], p[11]); w1.z = cvtpk(p[12], p[13]); w1.w = cvtpk(p[14], p[15]);
    const bf16x8 pf0 = __builtin_bit_cast(bf16x8, w0), pf1 = __builtin_bit_cast(bf16x8, w1);
#pragma unroll
    for (int dh = 0; dh < 2; ++dh) {
        const s16x4 a0 = v.f[dh][0], a1 = v.f[dh][1], b0 = v.f[dh][2], b1 = v.f[dh][3];
        const bf16x8 vf0 = {a0[0], a0[1], a0[2], a0[3], a1[0], a1[1], a1[2], a1[3]}, vf1 = {b0[0], b0[1], b0[2], b0[3], b1[0], b1[1], b1[2], b1[3]};
        st.o[dh] = __builtin_amdgcn_mfma_f32_32x32x16_bf16(vf0, pf0, st.o[dh], 0, 0, 0);
        st.o[dh] = __builtin_amdgcn_mfma_f32_32x32x16_bf16(vf1, pf1, st.o[dh], 0, 0, 0);
    }
}
__device__ __forceinline__ void attn_tile(const LAS unsigned char* kb, const LAS unsigned char* vb, const bf16x8 (&q)[4], AttnState& st, bool rowok, int lo, int hi, int lane) {
    const int r32 = lane & 31, h = lane >> 5;
    const bool live = rowok && lo <= hi && hi >= 0 && lo <= 63;
    if (!__any(live)) return;
    const bool full = rowok && lo <= 0 && hi >= 63;
    const bool rowmask_only = __all(full || !live);
    const float cm = (rowmask_only && !full) ? -INFINITY : 0.f;
    f32x16 cinit;
#pragma unroll
    for (int r = 0; r < 16; ++r) cinit[r] = st.negm[r] + cm;
    const LAS unsigned char* kp = kb + r32 * KROW + h * 16;
    f32x16 s0, s1;
    { const bf16x8 k0 = *(const LAS bf16x8*)(kp), k1 = *(const LAS bf16x8*)(kp + 32 * KROW);
      s0 = __builtin_amdgcn_mfma_f32_32x32x16_bf16(k0, q[0], cinit, 0, 0, 0);
      s1 = __builtin_amdgcn_mfma_f32_32x32x16_bf16(k1, q[0], cinit, 0, 0, 0); }
#pragma unroll
    for (int ks = 1; ks < 4; ++ks) {
        const bf16x8 k0 = *(const LAS bf16x8*)(kp + ks * 32), k1 = *(const LAS bf16x8*)(kp + 32 * KROW + ks * 32);
        s0 = __builtin_amdgcn_mfma_f32_32x32x16_bf16(k0, q[ks], s0, 0, 0, 0);
        s1 = __builtin_amdgcn_mfma_f32_32x32x16_bf16(k1, q[ks], s1, 0, 0, 0);
    }
    const LAS unsigned char* vp = vb + (4 * h + ((lane & 15) >> 2)) * VROW + (16 * ((lane >> 4) & 1) + 4 * (lane & 3)) * 2;
    const VFrags vf0 = v_preload(vp);
    __builtin_amdgcn_sched_barrier(0);
    if (!rowmask_only) {
#pragma unroll
        for (int r = 0; r < 16; ++r) { const int kk = (r & 3) + 8 * (r >> 2) + 4 * h;
            if (!(live && kk >= lo && kk <= hi)) s0[r] = -INFINITY;
            if (!(live && kk + 32 >= lo && kk + 32 <= hi)) s1[r] = -INFINITY; }
    }
    float mx = fmaxf(fmaxf(s0[0], s1[0]), fmaxf(s0[1], s1[1]));
#pragma unroll
    for (int r = 2; r < 16; r += 2) mx = fmaxf(fmaxf(mx, s0[r]), fmaxf(s1[r], fmaxf(s0[r + 1], s1[r + 1])));
    mx = fmaxf(mx, swap32(mx));
    if (__any(mx > 8.0f)) {
        const float d = fmaxf(mx, 0.f), alpha = __builtin_amdgcn_exp2f(-d);
        st.m += d; st.l *= alpha;
#pragma unroll
        for (int r = 0; r < 16; ++r) { s0[r] -= d; s1[r] -= d; st.o[0][r] *= alpha; st.o[1][r] *= alpha; st.negm[r] = -st.m; }
    }
    float ls0 = 0.f, ls1 = 0.f;
#pragma unroll
    for (int r = 0; r < 16; ++r) { s0[r] = __builtin_amdgcn_exp2f(s0[r]); s1[r] = __builtin_amdgcn_exp2f(s1[r]); ls0 += s0[r]; ls1 += s1[r]; }
    st.l += ls0 + ls1;
    const VFrags vf1 = v_preload(vp + 32 * VROW);
    pv_subtile_pre(st, vf0, s0);
    pv_subtile_pre(st, vf1, s1);
}
template <bool FIRST>
__device__ __forceinline__ void attn_fold(LAS float* yl, const AttnState& st, float gate) {
    const float lt = st.l + swap32(st.l); const float f = lt > 0.f ? gate / lt : 0.f;
#pragma unroll
    for (int dh = 0; dh < 2; ++dh)
#pragma unroll
        for (int r = 0; r < 16; ++r) { float v = f * st.o[dh][r]; if (!FIRST) v += yl[(dh * 16 + r) * 512]; yl[(dh * 16 + r) * 512] = v; }
}
struct KVRegs { u32x4 k, v; };
__device__ __forceinline__ KVRegs kv_load(const unsigned char* Kg, const unsigned char* Vg, int tile, int tid) {
    KVRegs r; r.k = *(const u32x4*)(Kg + (size_t)tile * 8192 + tid * 16); r.v = *(const u32x4*)(Vg + (size_t)tile * 8192 + tid * 16); return r; }
__device__ __forceinline__ void kv_store(LAS unsigned char* lds, const KVRegs& r, int buf, int tid) {
    *(LAS u32x4*)(lds + L_K + buf * 64 * KROW + (tid >> 3) * KROW + (tid & 7) * 16) = r.k;
    *(LAS u32x4*)(lds + L_V + buf * 64 * VROW + (tid >> 3) * VROW + (tid & 7) * 16) = r.v; }
#define LDS_BAR() asm volatile("s_waitcnt lgkmcnt(0)\n\ts_barrier" ::: "memory")
template <class MF>
__device__ __forceinline__ void attn_pass(LAS unsigned char* lds, const unsigned char* Kg, const unsigned char* Vg, int t_lo, int t_hi, const bf16x8 (&q)[4], AttnState& st, const MF& mf, int tid, int lane) {
    const int n = t_hi - t_lo + 1;
    KVRegs rA = kv_load(Kg, Vg, t_lo, tid), rB = rA;
    if (n > 1) rB = kv_load(Kg, Vg, t_lo + 1, tid);
    for (int i = 0; i < n; i += 2) {
        kv_store(lds, rA, 0, tid);
        LDS_BAR();
        if (i + 2 < n) rA = kv_load(Kg, Vg, t_lo + i + 2, tid);
        { bool rowok; int lo, hi; mf(t_lo + i, rowok, lo, hi);
          attn_tile(lds + L_K, lds + L_V, q, st, rowok, lo, hi, lane); }
        if (i + 1 < n) {
            kv_store(lds, rB, 1, tid);
            LDS_BAR();
            if (i + 3 < n) rB = kv_load(Kg, Vg, t_lo + i + 3, tid);
            bool rowok; int lo, hi; mf(t_lo + i + 1, rowok, lo, hi);
            attn_tile(lds + L_K + 64 * KROW, lds + L_V + 64 * VROW, q, st, rowok, lo, hi, lane);
        }
    }
    __syncthreads();
}
__device__ __forceinline__ void store_y(bf16_t* dst, const f32x16 (&y)[2], int h) {
#pragma unroll
    for (int dh = 0; dh < 2; ++dh)
#pragma unroll
        for (int g4 = 0; g4 < 4; ++g4) *(u32x2*)(dst + 32 * dh + 8 * g4 + 4 * h) = (u32x2){cvtpk(y[dh][4 * g4], y[dh][4 * g4 + 1]), cvtpk(y[dh][4 * g4 + 2], y[dh][4 * g4 + 3])};
}

__device__ __forceinline__ void nsa_unit(const Args& a, LAS unsigned char* lds, int b, int g, int qc, int tid, int lane, int wave) {
    unsigned char* ws = a.ws;
    const int r32 = lane & 31, h = lane >> 5, hl = wave >> 1, head = g * 4 + hl, tt = 32 * (wave & 1) + r32, t = 64 * qc + tt;
    const size_t row = (size_t)b * SEQ + t; const int bg = b * 2 + g;
    bf16x8 q[4];
    { const bf16_t* qp = (const bf16_t*)(ws + WS_QN) + ((size_t)(b * 8 + head) * SEQ + t) * 64 + 8 * h;
#pragma unroll
      for (int ks = 0; ks < 4; ++ks) q[ks] = *(const bf16x8*)(qp + 16 * ks); }
    const float* gn = (const float*)(ws + WS_GN) + row * 32 + head * 3; const float g_c = gn[0], g_s = gn[1], g_w = gn[2];
    LAS float* yl = (LAS float*)(lds + L_Y) + tid;
    {
        const unsigned char* Kg = ws + WS_KCC + (size_t)bg * 128 * 128; const unsigned char* Vg = ws + WS_VCC + (size_t)bg * 128 * 128;
#pragma unroll
        for (int i = 0; i < 2; ++i) { const int idx = tid + 512 * i; const u32x4 kk = *(const u32x4*)(Kg + idx * 16), vv = *(const u32x4*)(Vg + idx * 16);
            *(LAS u32x4*)(lds + L_K + (idx >> 3) * KROW + (idx & 7) * 16) = kk; *(LAS u32x4*)(lds + L_V + (idx >> 3) * VROW + (idx & 7) * 16) = vv; }
        __syncthreads();
        const int cmax = t >= 31 ? ((t - 31) >> 4) : -1;
        f32x16 s[4];
        const LAS unsigned char* kp = lds + L_K + r32 * KROW + h * 16;
#pragma unroll
        for (int p = 0; p < 4; ++p) {
#pragma unroll
            for (int r = 0; r < 16; ++r) s[p][r] = 0.f;
#pragma unroll
            for (int ks = 0; ks < 4; ++ks) s[p] = __builtin_amdgcn_mfma_f32_32x32x16_bf16(*(const LAS bf16x8*)(kp + p * 32 * KROW + ks * 32), q[ks], s[p], 0, 0, 0);
        }
        float mx = -INFINITY;
#pragma unroll
        for (int p = 0; p < 4; ++p)
#pragma unroll
            for (int r = 0; r < 16; ++r) { const int c = 32 * p + (r & 3) + 8 * (r >> 2) + 4 * h; if (c > cmax) s[p][r] = -INFINITY; mx = fmaxf(mx, s[p][r]); }
        mx = fmaxf(mx, swap32(mx));
        const float msafe = (mx == -INFINITY) ? 0.f : mx; float ls = 0.f;
#pragma unroll
        for (int p = 0; p < 4; ++p)
#pragma unroll
            for (int r = 0; r < 16; ++r) { s[p][r] = __builtin_amdgcn_exp2f(s[p][r] - msafe); ls += s[p][r]; }
        ls += swap32(ls);
        const float inv = 1.0f / fmaxf(ls, 1e-30f);
#pragma unroll
        for (int p = 0; p < 4; ++p)
#pragma unroll
            for (int r = 0; r < 16; ++r) s[p][r] *= inv;
        LAS float* imp = (LAS float*)(lds + L_IMP) + (hl * 64 + tt) * 33;
        AttnState st; attn_reset(st);
        const LAS unsigned char* vp = lds + L_V + (4 * h + ((lane & 15) >> 2)) * VROW + (16 * ((lane >> 4) & 1) + 4 * (lane & 3)) * 2;
        float eprev = 0.f;
#pragma unroll
        for (int p = 0; p < 4; ++p) {
#pragma unroll
            for (int g4 = 0; g4 < 4; ++g4) {
                const float Gv = (s[p][4 * g4] + s[p][4 * g4 + 1]) + (s[p][4 * g4 + 2] + s[p][4 * g4 + 3]);
                const float esw = swap32(s[p][4 * g4 + 3]);
                imp[8 * p + 2 * g4 + h] = Gv + (h ? esw : eprev);
                eprev = esw;
            }
            pv_subtile(st, vp + p * 32 * VROW, s[p]);
        }
#pragma unroll
        for (int dh = 0; dh < 2; ++dh)
#pragma unroll
            for (int r = 0; r < 16; ++r) yl[(dh * 16 + r) * 512] = g_c * st.o[dh][r];
        __syncthreads();
        {
            const int tok = tid >> 3, sub = tid & 7, cur = qc; unsigned msk;
            if (cur - 2 <= 5) msk = (cur >= 31) ? 0xffffffffu : ((1u << (cur + 1)) - 1u);
            else {
                const LAS float* ip = (const LAS float*)(lds + L_IMP) + tok * 33 + sub * 4;
                float v4[4];
#pragma unroll
                for (int jj = 0; jj < 4; ++jj) { const int j = sub * 4 + jj; const float vj = ((ip[jj] + ip[64 * 33 + jj]) + ip[2 * 64 * 33 + jj]) + ip[3 * 64 * 33 + jj]; v4[jj] = (j >= 1 && j <= cur - 2) ? vj : -1.f; }
                msk = 1u | (1u << cur) | (1u << (cur - 1));
#pragma unroll
                for (int pick = 0; pick < 5; ++pick) {
                    float bv = v4[0]; int bj = sub * 4;
#pragma unroll
                    for (int jj = 1; jj < 4; ++jj) if (v4[jj] > bv) { bv = v4[jj]; bj = sub * 4 + jj; }
#pragma unroll
                    for (int off = 1; off < 8; off <<= 1) { const float ov = __shfl_xor(bv, off); const int oj = __shfl_xor(bj, off); if (ov > bv || (ov == bv && oj < bj)) { bv = ov; bj = oj; } }
                    msk |= 1u << bj;
#pragma unroll
                    for (int jj = 0; jj < 4; ++jj) if (sub * 4 + jj == bj) v4[jj] = -1.f;
                }
            }
            if (sub == 0) ((LAS unsigned*)(lds + L_SEL))[tok] = msk;
        }
        __syncthreads();
    }
    const unsigned selm = ((const LAS unsigned*)(lds + L_SEL))[tt];
    {
        AttnState st; attn_reset(st);
        auto mf = [&](int j, bool& rowok, int& lo, int& hi) { rowok = (selm >> j) & 1u; lo = 0; hi = (j == qc) ? tt : 63; };
        attn_pass(lds, ws + WS_KS + (size_t)bg * SEQ * 128, ws + WS_VS + (size_t)bg * SEQ * 128, 0, qc, q, st, mf, tid, lane);
        attn_fold<false>(yl, st, g_s);
    }
    {
        AttnState st; attn_reset(st);
        const int jl = qc - 8;
        auto mf = [&](int j, bool& rowok, int& lo, int& hi) { rowok = true; lo = (j == jl) ? tt + 1 : 0; hi = (j == qc) ? tt : 63; };
        attn_pass(lds, ws + WS_KW + (size_t)bg * SEQ * 128, ws + WS_VW + (size_t)bg * SEQ * 128, jl < 0 ? 0 : jl, qc, q, st, mf, tid, lane);
        attn_fold<false>(yl, st, g_w);
    }
    f32x16 y[2];
#pragma unroll
    for (int dh = 0; dh < 2; ++dh)
#pragma unroll
        for (int r = 0; r < 16; ++r) y[dh][r] = yl[(dh * 16 + r) * 512];
    store_y((bf16_t*)(ws + WS_YN) + row * 512 + head * 64, y, h);
}

__device__ __forceinline__ void moba_unit(const Args& a, LAS unsigned char* lds, int b, int hd, int own, int tid, int lane, int wave) {
    unsigned char* ws = a.ws;
    const int r32 = lane & 31, h = lane >> 5, tb = 32 * wave + r32, t = 256 * own + tb;
    const size_t row = (size_t)b * SEQ + t; const int bh = b * 8 + hd;
    bf16x8 q[4];
    { const bf16_t* qp = (const bf16_t*)(ws + WS_QM) + ((size_t)bh * SEQ + t) * 64 + 8 * h;
#pragma unroll
      for (int ks = 0; ks < 4; ++ks) q[ks] = *(const bf16x8*)(qp + 16 * ks); }
    unsigned msk;
    if (own <= 3) msk = (1u << own) - 1u;
    else {
        { const float* km = (const float*)(ws + WS_KMEAN) + (size_t)bh * 8 * 64; ((LAS float*)(lds + L_KMEAN))[tid] = km[tid]; }
        __syncthreads();
        float sc[7];
#pragma unroll
        for (int n = 0; n < 7; ++n) { float d = 0.f;
            if (n < own) {
                const LAS float* kmn = (const LAS float*)(lds + L_KMEAN) + n * 64 + 8 * h;
#pragma unroll
                for (int ks = 0; ks < 4; ++ks)
#pragma unroll
                    for (int j = 0; j < 8; ++j) d += bf2f((unsigned short)q[ks][j]) * kmn[16 * ks + j];
                d += swap32(d);
            }
            sc[n] = d; }
        msk = 0u;
        for (int pick = 0; pick < 3; ++pick) { int best = 0; float bv = -INFINITY;
#pragma unroll
            for (int n = 0; n < 7; ++n) if (n < own && !((msk >> n) & 1u) && sc[n] > bv) { bv = sc[n]; best = n; }
            msk |= 1u << best; }
        __syncthreads();
    }
    AttnState st; attn_reset(st);
    auto mf = [&](int kt, bool& rowok, int& lo, int& hi) { const int n = kt >> 2; lo = 0;
        if (n < own) { rowok = (msk >> n) & 1u; hi = 63; } else { rowok = true; const int d = tb - 64 * (kt & 3); hi = d > 63 ? 63 : d; } };
    attn_pass(lds, ws + WS_KM + (size_t)bh * SEQ * 128, ws + WS_VM + (size_t)bh * SEQ * 128, 0, 4 * own + 3, q, st, mf, tid, lane);
    { const float lt = st.l + swap32(st.l); const float f = lt > 0.f ? 1.0f / lt : 0.f;
#pragma unroll
      for (int r = 0; r < 16; ++r) { st.o[0][r] *= f; st.o[1][r] *= f; } }
    store_y((bf16_t*)(ws + WS_YM) + row * 512 + hd * 64, st.o, h);
}

__device__ __forceinline__ bool decode_unit(int u, int& type, int& par, int& sub) {
    if (u < 1024) { type = 1; par = 7 - (u >> 7); sub = u & 127; return true; }
    u -= 1024;
    if (u < 1024) { type = 0; par = 31 - (u >> 5); sub = u & 31; return true; }
    return false;
}
__device__ __forceinline__ void attention_phase(const Args& a, LAS unsigned char* lds, int tid, int lane, int wave, int rep) {
    unsigned* ctr = (unsigned*)(a.ws + WS_CTL) + rep;
    unsigned* cflag = (unsigned*)(a.ws + WS_CTL) + 16 + rep;
    if (blockIdx.x < 32) {
        unsigned char* ws = a.ws;
        { SchedCmp S{(const char*)(ws + WS_KC), (const char*)(ws + WS_VC), (const char*)(ws + WS_WCK1), (const char*)(ws + WS_WCV1), (size_t)256 * 1024 * 2};
          EpiCmp1 E{(const float*)(ws + WS_B1), (bf16_t*)(ws + WS_HID)};
          pg8::gemm_phase(lds, 2048, 1024, 2048, S, E); }
        asm volatile("s_waitcnt vmcnt(0)" ::: "memory"); __builtin_amdgcn_fence(__ATOMIC_RELEASE, "agent"); __syncthreads(); __builtin_amdgcn_fence(__ATOMIC_ACQUIRE, "agent");
        { SchedCmp S{(const char*)(ws + WS_HID), (const char*)(ws + WS_HID) + (size_t)4096 * 256 * 2, (const char*)(ws + WS_WCK2), (const char*)(ws + WS_WCV2), (size_t)256 * 256 * 2};
          EpiCmp2 E{a.in[6], (const float*)(ws + WS_ROPE), (bf16_t*)(ws + WS_KCC), (bf16_t*)(ws + WS_VCC)};
          pg8::gemm_phase(lds, 256, 256, 256, S, E); }
        asm volatile("s_waitcnt vmcnt(0)" ::: "memory"); __builtin_amdgcn_fence(__ATOMIC_RELEASE, "agent"); __syncthreads();
        if (tid == 0) __hip_atomic_fetch_add(cflag, 1u, __ATOMIC_RELEASE, __HIP_MEMORY_SCOPE_AGENT);
    }
    bool cmp_ready = false;
    unsigned unext = 0u;
    if (tid == 0) unext = atomicAdd(ctr, 1u);
    for (;;) {
        if (tid == 0) ((LAS unsigned*)(lds + L_Q))[0] = unext;
        __syncthreads();
        const int u = (int)((LAS unsigned*)(lds + L_Q))[0];
        __syncthreads();
        int type, par, sub;
        if (!decode_unit(u, type, par, sub)) break;
        if (tid == 0) unext = atomicAdd(ctr, 1u);
        if (type == 0 && !cmp_ready) {
            if (tid == 0) { unsigned sp = 0; while (__hip_atomic_load(cflag, __ATOMIC_RELAXED, __HIP_MEMORY_SCOPE_AGENT) < 32u) { __builtin_amdgcn_s_sleep(8); if (++sp > (1u << 22)) break; } }
            __syncthreads(); __builtin_amdgcn_fence(__ATOMIC_ACQUIRE, "agent"); cmp_ready = true;
        }
        if (type == 0) nsa_unit(a, lds, sub >> 1, sub & 1, par, tid, lane, wave);
        else moba_unit(a, lds, sub >> 3, sub & 7, par, tid, lane, wave);
    }
}

#define XB_TMO      128
#define XB_XCNT(j)  (256  + 64 * (j))
#define XB_XSUB(j)  (1280 + 64 * (j))
#define XB_XGEN(j)  (2304 + 64 * (j))
#define XB_TOP      3328
#define XB_TOPGEN   3392
#define XCD_BAR_WORDS 3456
#define XB_SPIN_CAP (1u << 18)
__device__ __forceinline__ unsigned xb_ld(unsigned* p)              { return __hip_atomic_load(p, __ATOMIC_RELAXED, __HIP_MEMORY_SCOPE_AGENT); }
__device__ __forceinline__ unsigned xb_add(unsigned* p, unsigned v) { return __hip_atomic_fetch_add(p, v, __ATOMIC_RELAXED, __HIP_MEMORY_SCOPE_AGENT); }
__device__ __forceinline__ unsigned xb_xcc_id() { return (unsigned)__builtin_amdgcn_s_getreg((3 << 11) | 20) & 0xFu; }
#define XB_SPIN(cond, bar) do { unsigned _sp = 0; while (cond) { __builtin_amdgcn_s_sleep(1); \
    if ((++_sp & 255u) == 0u) { if (xb_ld(&(bar)[XB_TMO])) break; if (_sp > XB_SPIN_CAP) { atomicAdd(&(bar)[XB_TMO], 1u); break; } } } } while (0)
struct XcdBarrier { unsigned* bar; unsigned x; volatile LAS unsigned* st; };
__device__ __forceinline__ XcdBarrier xcd_barrier_post(unsigned* bar, volatile LAS unsigned* st) {
    XcdBarrier b; b.bar = bar; b.x = xb_xcc_id(); b.st = st;
    if (threadIdx.x == 0) (void)xb_add(&bar[XB_XCNT(b.x)], 1u);
    return b;
}
__device__ __forceinline__ void xcd_barrier_complete(unsigned* bar, unsigned x, unsigned& nloc, unsigned& nx) {
    const unsigned G = gridDim.x * gridDim.y * gridDim.z;
    unsigned sum, cnt, mine, sp = 0u;
    for (;;) {
        sum = 0u; cnt = 0u; mine = 0u;
#pragma unroll
        for (unsigned j = 0; j < 16; ++j) { const unsigned c = xb_ld(&bar[XB_XCNT(j)]); sum += c; cnt += (c > 0u) ? 1u : 0u; mine = (j == x) ? c : mine; }
        if (sum == G) break;
        __builtin_amdgcn_s_sleep(1);
        if ((++sp & 255u) == 0u) { if (xb_ld(&bar[XB_TMO])) break; if (sp > XB_SPIN_CAP) { atomicAdd(&bar[XB_TMO], 1u); break; } }
    }
    nloc = mine > 0u ? mine : 1u; nx = cnt > 0u ? cnt : 1u;
}
__device__ __forceinline__ void xcd_barrier(const XcdBarrier& b) {
    asm volatile("s_waitcnt vmcnt(0)" ::: "memory");
    __syncthreads();
    if (threadIdx.x == 0) {
        unsigned* bar = b.bar;
        __builtin_amdgcn_s_waitcnt(0);
        unsigned nloc = b.st[0], nx = b.st[1];
        if (nloc == 0u) { xcd_barrier_complete(bar, b.x, nloc, nx); b.st[0] = nloc; b.st[1] = nx; }
        const unsigned old = xb_add(&bar[XB_XSUB(b.x)], 1u);
        const unsigned gen = old / nloc;
        if (old + 1u == (gen + 1u) * nloc) {
            __builtin_amdgcn_fence(__ATOMIC_RELEASE, "agent");
            asm volatile("s_waitcnt vmcnt(0)" ::: "memory");
            const unsigned og = xb_add(&bar[XB_TOP], 1u);
            const unsigned tg = og / nx;
            if (og + 1u == (tg + 1u) * nx) xb_add(&bar[XB_TOPGEN], 1u);
            else XB_SPIN(xb_ld(&bar[XB_TOPGEN]) == tg, bar);
            __builtin_amdgcn_fence(__ATOMIC_ACQUIRE, "agent");
            xb_add(&bar[XB_XGEN(b.x)], 1u);
            asm volatile("s_waitcnt vmcnt(0)" ::: "memory");
        } else {
            XB_SPIN(xb_ld(&bar[XB_XGEN(b.x)]) == gen, bar);
            __builtin_amdgcn_fence(__ATOMIC_ACQUIRE, "agent");
            asm volatile("s_waitcnt vmcnt(0)" ::: "memory");
        }
    }
    __syncthreads();
}

constexpr int NPHASE = 10;
constexpr int LDS_BYTES = 147456, L_MISC = LDS_BYTES - 64;
constexpr int CW_BAR = 1024;
constexpr size_t CTL_ZERO_BYTES = 32768;
__global__ void __launch_bounds__(512) fwd_kernel(Args a) {
    extern __shared__ __attribute__((aligned(16))) unsigned char lds_raw[];
    LAS unsigned char* lds = (LAS unsigned char*)lds_raw;
    const int tid = threadIdx.x, lane = tid & 63, wave = __builtin_amdgcn_readfirstlane(tid >> 6);
    unsigned char* ws = a.ws;
    const int lo = a.ph_lo, hi = a.ph_hi;
#ifndef PH_MASK
#define PH_MASK 0x3ff
#endif
#define IN(k) (((PH_MASK >> (k)) & 1) && lo <= (k) && (k) < hi)
#define SEAM(k) do { if (IN(k) && IN((k) + ((k) == 2 ? 2 : 1))) { xcd_barrier(bar); } } while (0)
    volatile LAS unsigned* misc = (volatile LAS unsigned*)(lds + L_MISC);
    if (tid < 16) misc[tid] = 0u;
    __syncthreads();
    XcdBarrier bar = xcd_barrier_post((unsigned*)(ws + WS_CTL) + CW_BAR, misc);
    if (lo < 0) cg::this_grid().sync();
    if (IN(0)) { p0_prologue(a, lds, tid, lane, wave); }
    SEAM(0);
    if (IN(1)) {
        if (blockIdx.x == 0) { const float* pb = (const float*)(ws + WS_PBIAS); float s = 0.f; const int kv = tid >> 8, n = tid & 255;
            for (int c = 0; c < 32; ++c) s += pb[(size_t)(kv * 32 + c) * 256 + n];
            ((float*)(ws + WS_B1))[tid] = s; }
        SchedStd S; S.init(ws + WS_XB, DM, ws + WS_WIN, DM, T, IN_PAD, NREP(1));
        EpiProj E{(const float*)(ws + WS_RSTD0), (const float*)(ws + WS_ROPE), a.in[5], a.in[7], a.in[8], a.in[15], a.in[16],
                  (bf16_t*)(ws + WS_QN), (bf16_t*)(ws + WS_KC), (bf16_t*)(ws + WS_VC), (bf16_t*)(ws + WS_KS), (bf16_t*)(ws + WS_VS), (bf16_t*)(ws + WS_KW), (bf16_t*)(ws + WS_VW),
                  (bf16_t*)(ws + WS_QM), (bf16_t*)(ws + WS_KM), (bf16_t*)(ws + WS_VM), (bf16_t*)(ws + WS_GA), (bf16_t*)(ws + WS_GB), (float*)(ws + WS_GN)};
        pg8::gemm_phase(lds, DM, DM, DM, S, E);
    }
    SEAM(1);
    if (IN(2)) {
        kmean_phase(a, lane, wave);
        SchedStd S; S.init(ws + WS_PB, PLE, ws + WS_WPP, PLE, T, DM); EpiStoreBf16 E{(bf16_t*)(ws + WS_PP)}; pg8::gemm_phase(lds, PLE, PLE, PLE, S, E);
    }
    SEAM(2);
    if (IN(4)) { for (int rep = 0; rep < NREP(4); ++rep) attention_phase(a, lds, tid, lane, wave, rep); }
    SEAM(4);
    if (IN(5)) {
        SchedMerge S; S.init(ws + WS_YN, ws + WS_YM, ws + WS_WUPN, ws + WS_WUPM, 512, T, DM);
        EpiMerge E{(const bf16_t*)(ws + WS_GA), (const bf16_t*)(ws + WS_GB), (bf16_t*)(ws + WS_MB)};
        pg8::gemm_phase(lds, 512, 512, 512, S, E);
    }
    SEAM(5);
    if (IN(6)) {
        SchedStd S; S.init(ws + WS_MB, DM, ws + WS_WOUT, DM, T, DM);
        EpiResid<true> E{a.in[0], (bf16_t*)(ws + WS_XB), (float*)(ws + WS_RSSP)};
        pg8::gemm_phase(lds, DM, DM, DM, S, E);
    }
    SEAM(6);
    if (IN(7)) {
        SchedStd S; S.init(ws + WS_XB, DM, ws + WS_WFFI, DM, T, 2 * DFF, NREP(7));
        EpiFfnIn E{(const float*)(ws + WS_RSSP), (bf16_t*)(ws + WS_HB)};
        pg8::gemm_phase(lds, DM, DM, DM, S, E);
    }
    SEAM(7);
    if (IN(8)) {
        SchedStd S; S.init(ws + WS_HB, DFF, ws + WS_WFFO, DFF, T, DM);
        EpiResid<false> E{nullptr, (bf16_t*)(ws + WS_XB), (float*)(ws + WS_RSSP)};
        pg8::gemm_phase(lds, DFF, DFF, DFF, S, E);
    }
    SEAM(8);
    if (IN(9)) {
#ifndef NO_P9B
        { SchedStd S; S.init(ws + WS_XB, DM, ws + WS_WPG, DM, T, DM); EpiPle E{(const float*)(ws + WS_RSSP), (const bf16_t*)(ws + WS_PP), (const bf16_t*)(ws + WS_XB), a.out}; pg8::gemm_phase(lds, DM, DM, DM, S, E); }
#endif
    }
#undef IN
#undef SEAM
}

extern "C" void kernel_launch(void* const* d_in, const int* in_sizes, int n_in, void* d_out, int out_size, void* d_ws, size_t ws_size, hipStream_t stream) {
    static int grid = 0;
    if (grid == 0) {
        if (n_in != 26 || out_size != T * DM || ws_size < WS_END) { fprintf(stderr, "kernel_launch: unexpected shapes (n_in %d, out %d, ws %zu)\n", n_in, out_size, ws_size); grid = -1; return; }
        int dev = 0, cus = 0, per_cu = 0;
        hipGetDevice(&dev); hipDeviceGetAttribute(&cus, hipDeviceAttributeMultiprocessorCount, dev);
        if (hipFuncSetAttribute((const void*)fwd_kernel, hipFuncAttributeMaxDynamicSharedMemorySize, LDS_BYTES) != hipSuccess) { fprintf(stderr, "kernel_launch: hipFuncSetAttribute failed\n"); grid = -1; return; }
        if (hipOccupancyMaxActiveBlocksPerMultiprocessor(&per_cu, (const void*)fwd_kernel, 512, LDS_BYTES) != hipSuccess || per_cu < 1) { fprintf(stderr, "kernel_launch: occupancy query gave %d\n", per_cu); per_cu = 1; }
        (void)hipGetLastError();
        grid = cus * 1;
    }
    if (grid < 0) return;
    if (hipMemsetAsync((char*)d_ws + WS_CTL, 0, CTL_ZERO_BYTES, stream) != hipSuccess) { fprintf(stderr, "kernel_launch: memset failed\n"); return; }
    Args a{};
    for (int i = 0; i < 26; ++i) a.in[i] = (const float*)d_in[i];
    a.pos = (const int*)d_in[2]; a.out = (float*)d_out; a.ws = (unsigned char*)d_ws;
    for (int j = 0; j < 8; ++j) a.inv_freq[j] = powf(500000.0f, -(float)j / 8.0f);
#if MK_PER_PHASE
    for (int ph = 0; ph < NPHASE; ++ph) { a.ph_lo = ph; a.ph_hi = ph + 1; hipLaunchKernelGGL(fwd_kernel, dim3(grid), dim3(512), LDS_BYTES, stream, a); }
#else
    a.ph_lo = 0; a.ph_hi = NPHASE;
    void* args[] = {&a};
    hipError_t e = hipLaunchCooperativeKernel((const void*)fwd_kernel, dim3(grid), dim3(512), args, LDS_BYTES, stream);
    if (e != hipSuccess) fprintf(stderr, "cooperative launch failed: %s (grid %d)\n", hipGetErrorString(e), grid);
#endif
}
```

```cpp
#include <hip/hip_runtime.h>
#include <hip/hip_cooperative_groups.h>
#include <cstdio>
#include <cstdint>
#include <cmath>
namespace cg = cooperative_groups;

#ifndef MK_PER_PHASE
#define MK_PER_PHASE 0
#endif

#ifndef REPEAT_PHASE
#define REPEAT_PHASE 0
#endif
#define NREP(k) ((((REPEAT_PHASE) >> (k)) & 1) ? 2 : 1)
#define LAS __attribute__((address_space(3)))
typedef unsigned short bf16_t;
typedef short bf16x8 __attribute__((ext_vector_type(8)));
typedef short s16x4 __attribute__((ext_vector_type(4)));
typedef float f32x4 __attribute__((ext_vector_type(4)));
typedef float f32x16 __attribute__((ext_vector_type(16)));
typedef unsigned u32x4 __attribute__((ext_vector_type(4)));
typedef unsigned u32x2 __attribute__((ext_vector_type(2)));
typedef float f32x2_t __attribute__((ext_vector_type(2)));
typedef __bf16 bf16x2_t __attribute__((ext_vector_type(2)));

__device__ __forceinline__ unsigned cvtpk(float lo, float hi) { f32x2_t v = {lo, hi}; bf16x2_t b = __builtin_convertvector(v, bf16x2_t); return __builtin_bit_cast(unsigned, b); }
__device__ __forceinline__ float swap32(float v) { auto rr = __builtin_amdgcn_permlane32_swap(__builtin_bit_cast(unsigned, v), __builtin_bit_cast(unsigned, v), false, false); return __builtin_bit_cast(float, (threadIdx.x & 32) ? rr[0] : rr[1]); }
__device__ __forceinline__ float bf2f(unsigned short b) { return __builtin_bit_cast(float, (unsigned)b << 16); }
__device__ __forceinline__ float sigmoidf_(float x) { return __builtin_amdgcn_rcpf(1.0f + __builtin_amdgcn_exp2f(-1.4426950408889634f * x)); }

constexpr int DM = 1024, NB = 16, SEQ = 2048, T = NB * SEQ;
constexpr int HD = 64, NSA_H = 8, NSA_G = 2, MOBA_H = 8;
constexpr int NCMP = 127, NCMP_PAD = 128;
constexpr int DFF = 2816, PLE = 256, IN_COLS = 4888, IN_PAD = 5120;
constexpr float EPS = 1e-6f;
constexpr float C2 = 0.125f * 1.4426950408889634f;

constexpr size_t MiB = 1u << 20;
constexpr size_t WS_CTL = 0;
constexpr size_t WS_WIN = 1 * MiB, WS_WFFI = 11 * MiB, WS_WFFO = 22 * MiB, WS_WOUT = 28 * MiB, WS_WPG = 30 * MiB, WS_WUPN = 32 * MiB, WS_WUPM = 33 * MiB,
                 WS_WPP = 34 * MiB, WS_WCK1 = 35 * MiB, WS_WCV1 = 36 * MiB, WS_WCK2 = 37 * MiB, WS_WCV2 = 37 * MiB + 256 * 1024;
constexpr size_t WS_RSTD0 = 38 * MiB, WS_PBIAS = 38 * MiB + 256 * 1024, WS_B1 = 38 * MiB + 512 * 1024, WS_KMEAN = 39 * MiB, WS_KCC = 40 * MiB, WS_VCC = 41 * MiB,
                 WS_HID = 42 * MiB, WS_ROPE = 46 * MiB, WS_RSSP = 48 * MiB, WS_GN = 50 * MiB, WS_PB = 54 * MiB;
constexpr size_t WS_XB = 72 * MiB;
constexpr size_t WS_YN = 72 * MiB, WS_YM = 104 * MiB;
constexpr size_t WS_QN = 136 * MiB, WS_QM = 168 * MiB, WS_KM = 200 * MiB, WS_VM = 232 * MiB,
                 WS_KC = 264 * MiB, WS_VC = 272 * MiB, WS_KS = 280 * MiB, WS_VS = 288 * MiB, WS_KW = 296 * MiB, WS_VW = 304 * MiB;
constexpr size_t WS_MB = 136 * MiB, WS_HB = 136 * MiB;
constexpr size_t WS_GA = 312 * MiB, WS_GB = 376 * MiB, WS_PP = 440 * MiB, WS_END = 504 * MiB;

namespace pg8 {
constexpr int BM = 256, BK = 64, HALF = 128, HTB = HALF * BK * 2, STAGE_BYTES = 8 * HTB, NXCD = 8, WGM = 8;
__host__ __device__ __forceinline__ int lds_byte(int r, int c) { const int st = (r >> 4) * 2 + (c >> 5), rr = r & 15, cc = c & 31, ob = rr * 64 + cc * 2; return st * 1024 + (ob ^ (((ob >> 9) & 1) << 5)); }
__host__ __device__ __forceinline__ void stage_rc(int b, int& R, int& C) { const int st = b / 1024, sb = b % 1024, swz = sb ^ (((sb >> 9) & 1) << 5); R = (st >> 1) * 16 + swz / 64; C = (st & 1) * 32 + (swz % 64) / 2; }

struct Unit { int pm, pn, aux; const char* A; const char* B; };
struct StaticOrder {
    int nM, nN, nwg, G, c;
    __host__ __device__ void init(int M, int N, int G_, int c_) { nM = M / BM; nN = N / BM; nwg = nM * nN; G = G_; c = c_; }
    __host__ __device__ bool next(int i, int& pm, int& pn) const {
        const long L = (long)i * G + c; if (L >= nwg) return false;
        int wgid = (int)L; { const int q = nwg / NXCD, r = nwg % NXCD, xcd = wgid % NXCD, off = wgid / NXCD; wgid = (xcd < r ? xcd * (q + 1) : r * (q + 1) + (xcd - r) * q) + off; }
        const int nig = WGM * nN, gid = wgid / nig, fm = gid * WGM, gsz = (nM - fm) < WGM ? (nM - fm) : WGM;
        pm = fm + ((wgid % nig) % gsz); pn = (wgid % nig) / gsz; return true;
    }
};

template <class Epi, class Sched>
__device__ __forceinline__ void gemm_phase(LAS unsigned char* lds, const int K_in, const int lda, const int ldb, const Sched& S, const Epi& E) {
    int K = K_in; asm volatile("" : "+s"(K));
    const int tid = threadIdx.x, wid = __builtin_amdgcn_readfirstlane(tid >> 6), lane = tid & 63, wr = wid >> 2, wc = wid & 3, fr = lane & 15, fq = lane >> 4;
    const int nt = K / BK;
    unsigned voffA[2], voffB[2];
#pragma unroll
    for (int i = 0; i < 2; ++i) { int R, C; stage_rc(tid * 16 + i * 8192, R, C); voffA[i] = (unsigned)(R * lda + C) * 2u; voffB[i] = (unsigned)(R * ldb + C) * 2u; }
    const size_t kstep = (size_t)(BK * 2);
    const size_t hstepA = (size_t)HALF * lda * 2, hstepB = (size_t)HALF * ldb * 2;
    const unsigned ldsw = (unsigned)wid * 1024u;
    const int aoff = lds_byte(wr * 64 + fr, fq * 8), boff = lds_byte(wc * 32 + fr, fq * 8);
#define PG8_SA(b, h) (((b) * 2 + (h)) * HTB)
#define PG8_SB(b, h) ((4 + (b) * 2 + (h)) * HTB)
#define PG8_STAGE(bufoff, gbase, voff) do { _Pragma("unroll") for (int _i = 0; _i < 2; ++_i) \
        __builtin_amdgcn_global_load_lds((const unsigned*)((const char*)(gbase) + (voff)[_i]), (LAS unsigned*)(lds + (bufoff) + ldsw + _i * 8192), 16, 0, 0); } while (0)
#define PG8_LDA(dst, b, h) do { _Pragma("unroll") for (int m = 0; m < 4; ++m) _Pragma("unroll") for (int k = 0; k < 2; ++k) dst[m][k] = *(const LAS bf16x8*)(lds + PG8_SA(b, h) + aoff + m * 2048 + k * 1024); } while (0)
#define PG8_LDB(dst, b, h) do { _Pragma("unroll") for (int n = 0; n < 2; ++n) _Pragma("unroll") for (int k = 0; k < 2; ++k) dst[n][k] = *(const LAS bf16x8*)(lds + PG8_SB(b, h) + boff + n * 2048 + k * 1024); } while (0)
#define PG8_MMA(ai, bj, At, Bt) do { __builtin_amdgcn_s_setprio(1); _Pragma("unroll") for (int m = 0; m < 4; ++m) _Pragma("unroll") for (int n = 0; n < 2; ++n) _Pragma("unroll") for (int k = 0; k < 2; ++k) \
        acc[ai][bj][m][n] = __builtin_amdgcn_mfma_f32_16x16x32_bf16(Bt[n][k], At[m][k], acc[ai][bj][m][n], 0, 0, 0); __builtin_amdgcn_s_setprio(0); } while (0)
#define PG8_WAIT_V(n) asm volatile("s_waitcnt vmcnt(" #n ")" ::: "memory")
#define PG8_WAIT_L(n) asm volatile("s_waitcnt lgkmcnt(" #n ")" ::: "memory")
#define PG8_BAR __builtin_amdgcn_s_barrier()
#define PG8_SCHED __builtin_amdgcn_sched_barrier(0)
    Unit cur, nxt; int ui = 0;
    if (!S.next(0, cur)) return;
    f32x4 acc[2][2][4][2];
#pragma unroll
    for (int a = 0; a < 2; ++a)
#pragma unroll
        for (int b = 0; b < 2; ++b)
#pragma unroll
            for (int m = 0; m < 4; ++m)
#pragma unroll
                for (int n = 0; n < 2; ++n) acc[a][b][m][n] = (f32x4){0.f, 0.f, 0.f, 0.f};
    bf16x8 At[4][2], B0[2][2], B1[2][2];
    const char* cA = cur.A; const char* cB = cur.B;
    PG8_STAGE(PG8_SB(0, 0), cB, voffB); PG8_STAGE(PG8_SB(0, 1), cB + hstepB, voffB); PG8_STAGE(PG8_SA(0, 0), cA, voffA); PG8_STAGE(PG8_SA(0, 1), cA + hstepA, voffA);
    if (wr == 1) PG8_BAR;
    PG8_WAIT_V(2); PG8_BAR;
    PG8_STAGE(PG8_SB(1, 0), cB + kstep, voffB); PG8_STAGE(PG8_SA(1, 0), cA + kstep, voffA); PG8_STAGE(PG8_SB(1, 1), cB + hstepB + kstep, voffB);
    PG8_WAIT_V(6); PG8_BAR;
    for (;;) {
        const bool has_next = S.next(ui + 1, nxt);
        const char* nA = has_next ? nxt.A : cA; const char* nB = has_next ? nxt.B : cB;
        for (int t = 0; t < nt; t += 2) {
            const bool last = (t == nt - 2);
            const char* a1 = cA + (size_t)(t + 1) * kstep;
            const char* a2 = last ? nA : cA + (size_t)(t + 2) * kstep; const char* b2 = last ? nB : cB + (size_t)(t + 2) * kstep;
            const char* a3 = a2 + kstep; const char* b3 = b2 + kstep;
            PG8_LDB(B0, 0, 0); PG8_LDB(B1, 0, 1); PG8_SCHED; PG8_LDA(At, 0, 0); PG8_STAGE(PG8_SA(1, 1), a1 + hstepA, voffA);
            PG8_WAIT_V(8); PG8_WAIT_L(0); PG8_BAR; PG8_MMA(0, 0, At, B0); PG8_MMA(0, 1, At, B1); PG8_BAR; PG8_SCHED;
            PG8_LDA(At, 0, 1); PG8_STAGE(PG8_SB(0, 0), b2, voffB); PG8_STAGE(PG8_SB(0, 1), b2 + hstepB, voffB); PG8_STAGE(PG8_SA(0, 0), a2, voffA);
            PG8_WAIT_V(8); PG8_WAIT_L(0); PG8_BAR; PG8_MMA(1, 0, At, B0); PG8_MMA(1, 1, At, B1); PG8_BAR; PG8_SCHED;
            PG8_LDB(B0, 1, 0); PG8_LDB(B1, 1, 1); PG8_SCHED; PG8_LDA(At, 1, 0); PG8_STAGE(PG8_SA(0, 1), a2 + hstepA, voffA);
            PG8_WAIT_V(8); PG8_WAIT_L(0); PG8_BAR; PG8_MMA(0, 0, At, B0); PG8_MMA(0, 1, At, B1); PG8_BAR; PG8_SCHED;
            PG8_LDA(At, 1, 1); PG8_STAGE(PG8_SB(1, 0), b3, voffB); PG8_STAGE(PG8_SB(1, 1), b3 + hstepB, voffB); PG8_STAGE(PG8_SA(1, 0), a3, voffA);
            PG8_WAIT_V(8); PG8_WAIT_L(0); PG8_BAR; PG8_MMA(1, 0, At, B0); PG8_MMA(1, 1, At, B1); PG8_BAR; PG8_SCHED;
        }
        if (wr == 0) PG8_BAR;
        E(acc, cur, wr, wc, fr, fq);
        if (!has_next) break;
#pragma unroll
        for (int a = 0; a < 2; ++a)
#pragma unroll
            for (int b = 0; b < 2; ++b)
#pragma unroll
                for (int m = 0; m < 4; ++m)
#pragma unroll
                    for (int n = 0; n < 2; ++n) acc[a][b][m][n] = (f32x4){0.f, 0.f, 0.f, 0.f};
        cur = nxt; cA = nA; cB = nB; ++ui;
        if (wr == 1) PG8_BAR;
    }
    PG8_WAIT_V(0);
    PG8_BAR;
#undef PG8_SA
#undef PG8_SB
#undef PG8_STAGE
#undef PG8_LDA
#undef PG8_LDB
#undef PG8_MMA
#undef PG8_WAIT_V
#undef PG8_WAIT_L
#undef PG8_BAR
#undef PG8_SCHED
}
}
using pg8::Unit;
typedef f32x4 Acc[2][2][4][2];

__host__ __device__ __forceinline__ int phys_col(int L) { const int tile = L >> 8, l = L & 255, wc = l >> 6, fq = (l >> 4) & 3, bj = (l >> 3) & 1, n = (l >> 2) & 1, i = l & 3; return tile * 256 + 128 * bj + 32 * wc + 16 * n + 4 * fq + i; }

struct SchedStd {
    pg8::StaticOrder so; const char* A; const char* B; size_t a_tile, b_tile; int nmine, reps;
    __device__ __forceinline__ void init(const void* A_, int lda, const void* B_, int ldb, int M, int N, int reps_ = 1) { so.init(M, N, (int)gridDim.x, (int)blockIdx.x); A = (const char*)A_; B = (const char*)B_; a_tile = (size_t)256 * lda * 2; b_tile = (size_t)256 * ldb * 2;
        nmine = so.nwg > so.c ? (so.nwg - so.c + so.G - 1) / so.G : 0; reps = reps_; }
    __device__ __forceinline__ bool next(int i, Unit& u) const { int pm, pn; if (i >= nmine * reps) return false; so.next(i % nmine, pm, pn); u.pm = pm; u.pn = pn; u.aux = 0; u.A = A + (size_t)pm * a_tile; u.B = B + (size_t)pn * b_tile; return true; }
};
struct SchedMerge {
    pg8::StaticOrder so; const char* A0; const char* A1; const char* B0; const char* B1; size_t a_tile, b_tile; int nmine;
    __device__ __forceinline__ void init(const void* A0_, const void* A1_, const void* B0_, const void* B1_, int ld, int M, int N) { so.init(M, N, (int)gridDim.x, (int)blockIdx.x);
        A0 = (const char*)A0_; A1 = (const char*)A1_; B0 = (const char*)B0_; B1 = (const char*)B1_; a_tile = (size_t)256 * ld * 2; b_tile = (size_t)256 * ld * 2;
        nmine = so.nwg > so.c ? (so.nwg - so.c + so.G - 1) / so.G : 0; }
    __device__ __forceinline__ bool next(int i, Unit& u) const { int pm, pn; if (i >= 2 * nmine) return false; so.next(i >> 1, pm, pn); u.pm = pm; u.pn = pn; u.aux = i & 1;
        u.A = ((i & 1) ? A1 : A0) + (size_t)pm * a_tile; u.B = ((i & 1) ? B1 : B0) + (size_t)pn * b_tile; return true; }
};
struct SchedCmp {
    const char* A0; const char* A1; const char* B0; const char* B1; size_t a_tile;
    __device__ __forceinline__ bool next(int i, Unit& u) const { const int c = (int)blockIdx.x; if (i >= NREP(2) || c >= 32) return false; u.aux = c >> 4; u.pm = c & 15; u.pn = 0; u.A = (u.aux ? A1 : A0) + (size_t)u.pm * a_tile; u.B = u.aux ? B1 : B0; return true; }
};

#define EPI_ROWS_BEGIN _Pragma("unroll") for (int ai = 0; ai < 2; ++ai) _Pragma("unroll") for (int m = 0; m < 4; ++m) { const int row = u.pm * 256 + ai * 128 + wr * 64 + m * 16 + fr; float v[16]; \
    _Pragma("unroll") for (int bj = 0; bj < 2; ++bj) _Pragma("unroll") for (int n = 0; n < 2; ++n) _Pragma("unroll") for (int i = 0; i < 4; ++i) v[8 * bj + 4 * n + i] = acc[ai][bj][m][n][i];
#define EPI_ROWS_END }
__device__ __forceinline__ void store_bf16x16(bf16_t* dst, const float (&v)[16]) {
    u32x4 a, b; a.x = cvtpk(v[0], v[1]); a.y = cvtpk(v[2], v[3]); a.z = cvtpk(v[4], v[5]); a.w = cvtpk(v[6], v[7]);
    b.x = cvtpk(v[8], v[9]); b.y = cvtpk(v[10], v[11]); b.z = cvtpk(v[12], v[13]); b.w = cvtpk(v[14], v[15]);
    *(u32x4*)dst = a; *(u32x4*)(dst + 8) = b;
}
__device__ __forceinline__ float rstd_from_parts(const float* rssp, int row) {
    const f32x4* p = (const f32x4*)(rssp + (size_t)row * 16); const f32x4 a = p[0], b = p[1], c = p[2], d = p[3];
    const float s = ((a.x + a.y) + (a.z + a.w)) + ((b.x + b.y) + (b.z + b.w)) + ((c.x + c.y) + (c.z + c.w)) + ((d.x + d.y) + (d.z + d.w));
    return rsqrtf(s * (1.0f / DM) + EPS);
}

struct EpiProj {
    const float* rstd0; const float* rope; const float* gq; const float* gks; const float* gkw; const float* gmq; const float* gmk;
    bf16_t *QN, *KC, *VC, *KS, *VS, *KW, *VW, *QM, *KM, *VM, *GA, *GB; float* GN;
    __device__ __forceinline__ void operator()(const Acc& acc, const Unit& u, int wr, int wc, int fr, int fq) const {
        const int slot = u.pn * 4 + wc;
        int kind; bf16_t* base; const float* gain = nullptr; int nh = 1, hh = 0; bool ropeq = false; float sc = 1.f;
        if (slot < 8) { kind = 0; base = QN; gain = gq; nh = 8; hh = slot; ropeq = true; sc = C2; }
        else if (slot < 20) { const int s2 = slot - 8, which = s2 >> 1; kind = 0; nh = 2; hh = s2 & 1;
            base = which == 0 ? KC : which == 1 ? VC : which == 2 ? KS : which == 3 ? VS : which == 4 ? KW : VW;
            if (which == 2) { gain = gks; ropeq = true; } else if (which == 4) { gain = gkw; ropeq = true; } }
        else if (slot < 28) { kind = 0; base = QM; gain = gmq; nh = 8; hh = slot - 20; ropeq = true; sc = C2; }
        else if (slot < 36) { kind = 0; base = KM; gain = gmk; nh = 8; hh = slot - 28; ropeq = true; }
        else if (slot < 44) { kind = 0; base = VM; nh = 8; hh = slot - 36; }
        else if (slot < 60) { kind = 1; base = (bf16_t*)((unsigned char*)GA + (slot - 44) * 64); }
        else if (slot < 76) { kind = 1; base = (bf16_t*)((unsigned char*)GB + (slot - 60) * 64); }
        else if (slot == 76) { kind = 2; base = nullptr; }
        else return;
        float g16[16];
        if (gain) {
#pragma unroll
            for (int c = 0; c < 16; ++c) g16[c] = gain[16 * fq + c] * sc;
        }
        EPI_ROWS_BEGIN
            const float rs = rstd0[row];
            if (kind == 0) {
                if (gain) {
                    float ss = 0.f;
#pragma unroll
                    for (int c = 0; c < 16; ++c) ss += v[c] * v[c];
                    ss += __shfl_xor(ss, 16); ss += __shfl_xor(ss, 32);
                    const float f = rs * rsqrtf(rs * rs * ss * (1.0f / 64.0f) + EPS);
#pragma unroll
                    for (int c = 0; c < 16; ++c) v[c] = v[c] * f * g16[c];
                } else {
#pragma unroll
                    for (int c = 0; c < 16; ++c) v[c] *= rs;
                }
                if (ropeq && fq == 0) {
                    const f32x4* rp = (const f32x4*)(rope + (size_t)row * 16); const f32x4 c0 = rp[0], c1 = rp[1], s0 = rp[2], s1 = rp[3];
                    const float cs[8] = {c0.x, c0.y, c0.z, c0.w, c1.x, c1.y, c1.z, c1.w}, sn[8] = {s0.x, s0.y, s0.z, s0.w, s1.x, s1.y, s1.z, s1.w};
#pragma unroll
                    for (int j = 0; j < 8; ++j) { const float a = v[j], b = v[j + 8]; v[j] = a * cs[j] - b * sn[j]; v[j + 8] = b * cs[j] + a * sn[j]; }
                }
                const int b = row >> 11, t = row & (SEQ - 1);
                store_bf16x16(base + ((size_t)(b * nh + hh) * SEQ + t) * 64 + 16 * fq, v);
            } else if (kind == 1) {
                const float kexp = -1.4426950408889634f * rs;
                unsigned w[4];
#pragma unroll
                for (int c4 = 0; c4 < 4; ++c4) { unsigned pk = 0u;
#pragma unroll
                    for (int i = 0; i < 4; ++i) { const float e = __builtin_amdgcn_exp2f(v[4 * c4 + i] * kexp);
                        pk = __builtin_amdgcn_cvt_pk_u8_f32(__builtin_amdgcn_rcpf(__builtin_fmaf(e, 1.0f / 255.0f, 1.0f / 255.0f)), i, pk); }
                    w[c4] = pk; }
                *(u32x4*)((unsigned char*)base + (size_t)row * DM + 16 * fq) = (u32x4){w[0], w[1], w[2], w[3]};
            } else {
                if (fq < 2) {
#pragma unroll
                    for (int c = 0; c < 16; ++c) v[c] = sigmoidf_(v[c] * rs);
                    f32x4* d = (f32x4*)(GN + (size_t)row * 32 + 16 * fq);
                    d[0] = (f32x4){v[0], v[1], v[2], v[3]}; d[1] = (f32x4){v[4], v[5], v[6], v[7]};
                    if (fq == 0) { d[2] = (f32x4){v[8], v[9], v[10], v[11]}; d[3] = (f32x4){v[12], v[13], v[14], v[15]}; }
                }
            }
        EPI_ROWS_END
    }
};
struct EpiCmp1 {
    const float* b1; bf16_t* hid;
    __device__ __forceinline__ void operator()(const Acc& acc, const Unit& u, int wr, int wc, int fr, int fq) const {
        float bb[16];
#pragma unroll
        for (int c = 0; c < 16; ++c) bb[c] = b1[u.aux * 256 + 64 * wc + 16 * fq + c];
        bf16_t* H = hid + (size_t)u.aux * 4096 * 256;
        EPI_ROWS_BEGIN
#pragma unroll
            for (int c = 0; c < 16; ++c) { const float x = v[c] + bb[c]; v[c] = x * sigmoidf_(x); }
            store_bf16x16(H + (size_t)row * 256 + 64 * wc + 16 * fq, v);
        EPI_ROWS_END
    }
};
struct EpiCmp2 {
    const float* gkc; const float* rope; bf16_t* KCC; bf16_t* VCC;
    __device__ __forceinline__ void operator()(const Acc& acc, const Unit& u, int wr, int wc, int fr, int fq) const {
        if (wc != 0) return;
        float g16[16];
#pragma unroll
        for (int c = 0; c < 16; ++c) g16[c] = gkc[16 * fq + c];
        EPI_ROWS_BEGIN
            const int bg = row >> 7, c_ = row & 127, b = bg >> 1;
            if (u.aux == 0) {
                float ss = 0.f;
#pragma unroll
                for (int c = 0; c < 16; ++c) ss += v[c] * v[c];
                ss += __shfl_xor(ss, 16); ss += __shfl_xor(ss, 32);
                const float rn = rsqrtf(ss * (1.0f / 64.0f) + EPS);
#pragma unroll
                for (int c = 0; c < 16; ++c) v[c] = v[c] * rn * g16[c];
                if (fq == 0) {
                    int tp = c_ * 16 + 31; if (tp > SEQ - 1) tp = SEQ - 1;
                    const f32x4* rp = (const f32x4*)(rope + ((size_t)b * SEQ + tp) * 16); const f32x4 c0 = rp[0], c1 = rp[1], s0 = rp[2], s1 = rp[3];
                    const float cs[8] = {c0.x, c0.y, c0.z, c0.w, c1.x, c1.y, c1.z, c1.w}, sn[8] = {s0.x, s0.y, s0.z, s0.w, s1.x, s1.y, s1.z, s1.w};
#pragma unroll
                    for (int j = 0; j < 8; ++j) { const float a = v[j], bq = v[j + 8]; v[j] = a * cs[j] - bq * sn[j]; v[j + 8] = bq * cs[j] + a * sn[j]; }
                }
                store_bf16x16(KCC + (size_t)row * 64 + 16 * fq, v);
            } else {
                store_bf16x16(VCC + (size_t)row * 64 + 16 * fq, v);
            }
        EPI_ROWS_END
    }
};
struct EpiMerge {
    const bf16_t* GA; const bf16_t* GB; bf16_t* MB;
    __device__ __forceinline__ void operator()(const Acc& acc, const Unit& u, int wr, int wc, int fr, int fq) const {
        const int col = u.pn * 256 + 64 * wc + 16 * fq;
        const unsigned char* G = (const unsigned char*)(u.aux ? GB : GA);
        EPI_ROWS_BEGIN
            const u32x4 g0 = *(const u32x4*)(G + (size_t)row * DM + col);
            const unsigned gw[4] = {g0.x, g0.y, g0.z, g0.w};
#pragma unroll
            for (int c = 0; c < 16; ++c) v[c] *= (float)((gw[c >> 2] >> (8 * (c & 3))) & 255u) * (1.0f / 255.0f);
            bf16_t* mp = MB + (size_t)row * DM + col;
            if (u.aux) {
                const u32x4 m0 = ((const u32x4*)mp)[0], m1 = ((const u32x4*)mp)[1];
                const unsigned mw[8] = {m0.x, m0.y, m0.z, m0.w, m1.x, m1.y, m1.z, m1.w};
#pragma unroll
                for (int c = 0; c < 8; ++c) { v[2 * c] += __builtin_bit_cast(float, mw[c] << 16); v[2 * c + 1] += __builtin_bit_cast(float, mw[c] & 0xffff0000u); }
            }
            store_bf16x16(mp, v);
        EPI_ROWS_END
    }
};
template <bool XF32> struct EpiResid {
    const float* xi; bf16_t* xb; float* rssp;
    __device__ __forceinline__ void operator()(const Acc& acc, const Unit& u, int wr, int wc, int fr, int fq) const {
        const int col = u.pn * 256 + 64 * wc + 16 * fq;
        EPI_ROWS_BEGIN
            bf16_t* bp = xb + (size_t)row * DM + col;
            if (XF32) { const f32x4* ip = (const f32x4*)(xi + (size_t)row * DM + col);
#pragma unroll
                for (int q = 0; q < 4; ++q) { const f32x4 x = ip[q]; v[4 * q] += x.x; v[4 * q + 1] += x.y; v[4 * q + 2] += x.z; v[4 * q + 3] += x.w; } }
            else { const u32x4 m0 = ((const u32x4*)bp)[0], m1 = ((const u32x4*)bp)[1]; const unsigned mw[8] = {m0.x, m0.y, m0.z, m0.w, m1.x, m1.y, m1.z, m1.w};
#pragma unroll
                for (int c = 0; c < 8; ++c) { v[2 * c] += __builtin_bit_cast(float, mw[c] << 16); v[2 * c + 1] += __builtin_bit_cast(float, mw[c] & 0xffff0000u); } }
            float ss = 0.f;
#pragma unroll
            for (int c = 0; c < 16; ++c) ss += v[c] * v[c];
            store_bf16x16(bp, v);
            ss += __shfl_xor(ss, 16); ss += __shfl_xor(ss, 32);
            if (fq == 0) rssp[(size_t)row * 16 + u.pn * 4 + wc] = ss;
        EPI_ROWS_END
    }
};
struct EpiFfnIn {
    const float* rssp; bf16_t* HB;
    __device__ __forceinline__ void operator()(const Acc& acc, const Unit& u, int wr, int wc, int fr, int fq) const {
        const int hcol = u.pn * 128 + 32 * wc + 8 * fq;
        EPI_ROWS_BEGIN
            const float rs = rstd_from_parts(rssp, row);
            float h[8];
            const float kexp = -1.4426950408889634f * rs, irs2 = __builtin_amdgcn_rcpf(rs * rs);
#pragma unroll
            for (int c = 0; c < 8; ++c) { const float e = __builtin_amdgcn_exp2f(v[c] * kexp); h[c] = (v[c] * v[c + 8]) * __builtin_amdgcn_rcpf(__builtin_fmaf(e, irs2, irs2)); }
            u32x4 w; w.x = cvtpk(h[0], h[1]); w.y = cvtpk(h[2], h[3]); w.z = cvtpk(h[4], h[5]); w.w = cvtpk(h[6], h[7]);
            *(u32x4*)(HB + (size_t)row * DFF + hcol) = w;
        EPI_ROWS_END
    }
};
struct EpiStoreBf16 {
    bf16_t* PP;
    __device__ __forceinline__ void operator()(const Acc& acc, const Unit& u, int wr, int wc, int fr, int fq) const {
        const int col = u.pn * 256 + 64 * wc + 16 * fq;
        EPI_ROWS_BEGIN
            store_bf16x16(PP + (size_t)row * DM + col, v);
        EPI_ROWS_END
    }
};
struct EpiPle {
    const float* rssp; const bf16_t* PP; const bf16_t* xb; float* out;
    __device__ __forceinline__ void operator()(const Acc& acc, const Unit& u, int wr, int wc, int fr, int fq) const {
        const int col = u.pn * 256 + 64 * wc + 16 * fq;
        EPI_ROWS_BEGIN
            const float rs = rstd_from_parts(rssp, row); const float kexp = -1.4426950408889634f * rs;
            const u32x4* pp = (const u32x4*)(PP + (size_t)row * DM + col); const u32x4* xp = (const u32x4*)(xb + (size_t)row * DM + col);
            const u32x4 p0 = pp[0], p1 = pp[1], x0 = xp[0], x1 = xp[1];
            const unsigned pw[8] = {p0.x, p0.y, p0.z, p0.w, p1.x, p1.y, p1.z, p1.w}, xw[8] = {x0.x, x0.y, x0.z, x0.w, x1.x, x1.y, x1.z, x1.w};
#pragma unroll
            for (int c = 0; c < 8; ++c) {
                v[2 * c] = __builtin_fmaf(__builtin_amdgcn_rcpf(1.0f + __builtin_amdgcn_exp2f(v[2 * c] * kexp)), __builtin_bit_cast(float, pw[c] << 16), __builtin_bit_cast(float, xw[c] << 16));
                v[2 * c + 1] = __builtin_fmaf(__builtin_amdgcn_rcpf(1.0f + __builtin_amdgcn_exp2f(v[2 * c + 1] * kexp)), __builtin_bit_cast(float, pw[c] & 0xffff0000u), __builtin_bit_cast(float, xw[c] & 0xffff0000u)); }
            f32x4* op = (f32x4*)(out + (size_t)row * DM + col);
#pragma unroll
            for (int q = 0; q < 4; ++q) op[q] = (f32x4){v[4 * q], v[4 * q + 1], v[4 * q + 2], v[4 * q + 3]};
        EPI_ROWS_END
    }
};

struct Args {
    const float* in[26]; const int* pos; float* out; unsigned char* ws;
    float inv_freq[8];
    int ph_lo, ph_hi;
};

__device__ __forceinline__ float wave_sum(float v) {
#pragma unroll
    for (int o = 1; o < 64; o <<= 1) v += __shfl_xor(v, o);
    return v;
}
__device__ __forceinline__ int srccol_win(int L) { if (L < 1280) return L; if (L < 4864) return L + 24; if (L < 4888) return 1280 + (L - 4864); return -1; }
__device__ __forceinline__ int srccol_ffi(int L) { const int tile = L >> 8, l = L & 255, wq = l >> 4, jj = l & 15; const int hid = tile * 128 + wq * 8 + (jj & 7); return (jj < 8 ? 0 : DFF) + hid; }
template <int MAP>
__device__ __forceinline__ void transpose_item(const float* W, int K, int ldw, int nvalid, const float* gain, bf16_t* WT, LAS float* scr, int item, int nblk, int lane) {
    const int kb = item / nblk, nb = item % nblk, k0 = 32 * kb, n0 = 64 * nb;
    const int L = n0 + lane; const int sc = MAP == 1 ? srccol_win(L) : MAP == 2 ? srccol_ffi(L) : (L < nvalid ? L : -1);
    float xv[32];
#pragma unroll
    for (int i = 0; i < 32; ++i) xv[i] = sc >= 0 ? __builtin_nontemporal_load(W + (size_t)(k0 + i) * ldw + sc) : 0.f;
#pragma unroll
    for (int i = 0; i < 32; ++i) { float x = xv[i]; if (gain) x *= gain[k0 + i]; scr[i * 65 + lane] = x; }
    asm volatile("s_waitcnt lgkmcnt(0)" ::: "memory");
    const int ch = lane & 3;
#pragma unroll
    for (int j = 0; j < 4; ++j) { const int nn = (lane >> 2) + 16 * j; const LAS float* s = scr + (8 * ch) * 65 + nn;
        u32x4 o; o.x = cvtpk(s[0], s[65]); o.y = cvtpk(s[2 * 65], s[3 * 65]); o.z = cvtpk(s[4 * 65], s[5 * 65]); o.w = cvtpk(s[6 * 65], s[7 * 65]);
        *(u32x4*)(WT + (size_t)phys_col(n0 + nn) * K + k0 + 8 * ch) = o; }
    asm volatile("s_waitcnt lgkmcnt(0)" ::: "memory");
}

__device__ __forceinline__ void p0_prologue(const Args& a, LAS unsigned char* lds, int tid, int lane, int wave) {
    unsigned char* ws = a.ws;
    LAS float* scr = (LAS float*)(lds + wave * 16384);
    const int gw = (int)blockIdx.x * 8 + wave, NGW = (int)gridDim.x * 8;
    constexpr int I_WIN = 32 * 80, I_UP = 16 * 16, I_OUT = 32 * 16, I_FFI = 32 * 88, I_FFO = 88 * 16, I_PG = 32 * 16, I_PP = 8 * 16, I_C1 = 64 * 4, I_C2 = 8 * 4;
    constexpr int NIT = I_WIN + 2 * I_UP + I_OUT + I_FFI + I_FFO + I_PG + I_PP + 2 * I_C1 + 2 * I_C2;
    for (int it0 = gw; it0 < NIT * NREP(0); it0 += NGW) {
        int r = it0 % NIT;
        if (r < I_WIN) { transpose_item<1>(a.in[4], 1024, IN_COLS, 0, a.in[3], (bf16_t*)(ws + WS_WIN), scr, r, 80, lane); continue; } r -= I_WIN;
        if (r < I_FFI) { transpose_item<2>(a.in[21], 1024, 2 * DFF, 0, a.in[20], (bf16_t*)(ws + WS_WFFI), scr, r, 88, lane); continue; } r -= I_FFI;
        if (r < I_FFO) { transpose_item<0>(a.in[22], DFF, 1024, 1024, nullptr, (bf16_t*)(ws + WS_WFFO), scr, r, 16, lane); continue; } r -= I_FFO;
        if (r < I_OUT) { transpose_item<0>(a.in[19], 1024, 1024, 1024, nullptr, (bf16_t*)(ws + WS_WOUT), scr, r, 16, lane); continue; } r -= I_OUT;
        if (r < I_PG) { transpose_item<0>(a.in[24], 1024, 1024, 1024, a.in[23], (bf16_t*)(ws + WS_WPG), scr, r, 16, lane); continue; } r -= I_PG;
        if (r < I_UP) { transpose_item<0>(a.in[17], 512, 1024, 1024, nullptr, (bf16_t*)(ws + WS_WUPN), scr, r, 16, lane); continue; } r -= I_UP;
        if (r < I_UP) { transpose_item<0>(a.in[18], 512, 1024, 1024, nullptr, (bf16_t*)(ws + WS_WUPM), scr, r, 16, lane); continue; } r -= I_UP;
        if (r < I_PP) { transpose_item<0>(a.in[25], 256, 1024, 1024, nullptr, (bf16_t*)(ws + WS_WPP), scr, r, 16, lane); continue; } r -= I_PP;
        if (r < I_C1) { transpose_item<0>(a.in[11], 2048, 256, 256, nullptr, (bf16_t*)(ws + WS_WCK1), scr, r, 4, lane); continue; } r -= I_C1;
        if (r < I_C1) { transpose_item<0>(a.in[13], 2048, 256, 256, nullptr, (bf16_t*)(ws + WS_WCV1), scr, r, 4, lane); continue; } r -= I_C1;
        if (r < I_C2) { transpose_item<0>(a.in[12], 256, 64, 64, nullptr, (bf16_t*)(ws + WS_WCK2), scr, r, 4, lane); continue; } r -= I_C2;
        transpose_item<0>(a.in[14], 256, 64, 64, nullptr, (bf16_t*)(ws + WS_WCV2), scr, r, 4, lane);
    }
    {
        const float* x = a.in[0]; bf16_t* XB = (bf16_t*)(ws + WS_XB); float* rstd0 = (float*)(ws + WS_RSTD0);
        const float* p = a.in[1]; bf16_t* PB = (bf16_t*)(ws + WS_PB);
        for (int m0 = gw; m0 < T * NREP(0); m0 += NGW) { const int m = m0 % T;
            const f32x4* xr = (const f32x4*)(x + (size_t)m * DM) + lane; f32x4 v[4]; float s = 0.f;
#pragma unroll
            for (int j = 0; j < 4; ++j) { v[j] = __builtin_nontemporal_load(xr + 64 * j); s += (v[j].x * v[j].x + v[j].y * v[j].y) + (v[j].z * v[j].z + v[j].w * v[j].w); }
            const f32x4 pv = __builtin_nontemporal_load((const f32x4*)(p + (size_t)m * PLE) + lane);
            s = wave_sum(s);
            if (lane == 0) rstd0[m] = rsqrtf(s * (1.0f / DM) + EPS);
            u32x2* o8 = (u32x2*)(XB + (size_t)m * DM) + lane;
#pragma unroll
            for (int j = 0; j < 4; ++j) o8[64 * j] = (u32x2){cvtpk(v[j].x, v[j].y), cvtpk(v[j].z, v[j].w)};
            ((u32x2*)(PB + (size_t)m * PLE))[lane] = (u32x2){cvtpk(pv.x, pv.y), cvtpk(pv.z, pv.w)};
        }
    }
    {
        float* rope = (float*)(ws + WS_ROPE); const int gt = (int)blockIdx.x * 512 + tid, NGT = (int)gridDim.x * 512;
        const float f0 = a.inv_freq[0], f1 = a.inv_freq[1], f2 = a.inv_freq[2], f3 = a.inv_freq[3], f4 = a.inv_freq[4], f5 = a.inv_freq[5], f6 = a.inv_freq[6], f7 = a.inv_freq[7];
        for (int row0 = gt; row0 < T * NREP(0); row0 += NGT) { const int row = row0 % T; const float pf = (float)a.pos[row]; const float fr8[8] = {f0, f1, f2, f3, f4, f5, f6, f7}; float cs[8], sn[8];
#pragma unroll
            for (int j = 0; j < 8; ++j) { const float ang = pf * fr8[j]; double rev = (double)ang * 0.15915494309189535; rev -= floor(rev); const float fr = (float)rev;
                cs[j] = __builtin_amdgcn_cosf(fr); sn[j] = __builtin_amdgcn_sinf(fr); }
            f32x4* o = (f32x4*)(rope + (size_t)row * 16);
            o[0] = (f32x4){cs[0], cs[1], cs[2], cs[3]}; o[1] = (f32x4){cs[4], cs[5], cs[6], cs[7]}; o[2] = (f32x4){sn[0], sn[1], sn[2], sn[3]}; o[3] = (f32x4){sn[4], sn[5], sn[6], sn[7]}; }
    }
    {
        float* pb = (float*)(ws + WS_PBIAS);
        for (int it = gw; it < 64; it += NGW) { const int kv = it >> 5, kc = it & 31; const float* pe = kv ? a.in[10] : a.in[9]; const float* w1 = kv ? a.in[13] : a.in[11];
            float s0 = 0.f, s1 = 0.f, s2 = 0.f, s3 = 0.f;
#pragma unroll 16
            for (int kk = 0; kk < 64; ++kk) { const int k = kc * 64 + kk; const float pv = pe[k]; const float* wr = w1 + (size_t)k * 256 + lane;
                s0 += pv * wr[0]; s1 += pv * wr[64]; s2 += pv * wr[128]; s3 += pv * wr[192]; }
            float* o = pb + (size_t)(kv * 32 + kc) * 256 + lane; o[0] = s0; o[64] = s1; o[128] = s2; o[192] = s3; }
    }
}

__device__ __forceinline__ void kmean_phase(const Args& a, int lane, int wave) {
    const bf16_t* KM = (const bf16_t*)(a.ws + WS_KM); float* KMEAN = (float*)(a.ws + WS_KMEAN);
    const int gw = (int)blockIdx.x * 8 + wave, NGW = (int)gridDim.x * 8;
    for (int it0 = gw; it0 < NB * MOBA_H * 8 * NREP(2); it0 += NGW) { const int it = it0 % (NB * MOBA_H * 8);
        const u32x4* src = (const u32x4*)(KM + (size_t)it * 256 * 64) + lane; float s[8];
#pragma unroll
        for (int c = 0; c < 8; ++c) s[c] = 0.f;
        u32x4 wv[32];
#pragma unroll
        for (int i = 0; i < 32; ++i) wv[i] = src[64 * i];
#pragma unroll
        for (int i = 0; i < 32; ++i) { const u32x4 w = wv[i]; const unsigned ww[4] = {w.x, w.y, w.z, w.w};
#pragma unroll
            for (int c = 0; c < 4; ++c) { s[2 * c] += __builtin_bit_cast(float, ww[c] << 16); s[2 * c + 1] += __builtin_bit_cast(float, ww[c] & 0xffff0000u); } }
#pragma unroll
        for (int c = 0; c < 8; ++c) { s[c] += __shfl_xor(s[c], 8); s[c] += __shfl_xor(s[c], 16); s[c] += __shfl_xor(s[c], 32); }
        if (lane < 8) { f32x4* o = (f32x4*)(KMEAN + (size_t)it * 64 + lane * 8);
            o[0] = (f32x4){s[0], s[1], s[2], s[3]} * (1.0f / 256.0f); o[1] = (f32x4){s[4], s[5], s[6], s[7]} * (1.0f / 256.0f); }
    }
}

constexpr int KROW = 144, VROW = 192;
constexpr int L_K = 0, L_V = 2 * 64 * KROW, L_IMP = L_V + 2 * 64 * VROW, L_SEL = L_IMP + 4 * 64 * 33 * 4, L_KMEAN = L_SEL + 256, L_Q = L_KMEAN + 2048, L_Y = L_Q + 64, L_ATT_END = L_Y + 65536;
static_assert(L_ATT_END <= 147456, "attention LDS");
struct AttnState { float m, l; f32x16 o[2]; f32x16 negm; };
__device__ __forceinline__ void attn_reset(AttnState& st) { st.m = 0.f; st.l = 0.f;
#pragma unroll
    for (int r = 0; r < 16; ++r) { st.o[0][r] = 0.f; st.o[1][r] = 0.f; st.negm[r] = 0.f; } }
__device__ __forceinline__ s16x4 vtr(const LAS unsigned char* p) { return __builtin_bit_cast(s16x4, __builtin_amdgcn_ds_read_tr16_b64_v4i16((LAS s16x4*)p)); }
__device__ __forceinline__ void pv_subtile(AttnState& st, const LAS unsigned char* vb, const f32x16& p) {
    u32x4 w0, w1; w0.x = cvtpk(p[0], p[1]); w0.y = cvtpk(p[2], p[3]); w0.z = cvtpk(p[4], p[5]); w0.w = cvtpk(p[6], p[7]);
    w1.x = cvtpk(p[8], p[9]); w1.y = cvtpk(p[10], p[11]); w1.z = cvtpk(p[12], p[13]); w1.w = cvtpk(p[14], p[15]);
    const bf16x8 pf0 = __builtin_bit_cast(bf16x8, w0), pf1 = __builtin_bit_cast(bf16x8, w1);
#pragma unroll
    for (int dh = 0; dh < 2; ++dh) {
        const s16x4 a0 = vtr(vb + dh * 64), a1 = vtr(vb + dh * 64 + 8 * VROW), b0 = vtr(vb + dh * 64 + 16 * VROW), b1 = vtr(vb + dh * 64 + 24 * VROW);
        const bf16x8 vf0 = {a0[0], a0[1], a0[2], a0[3], a1[0], a1[1], a1[2], a1[3]}, vf1 = {b0[0], b0[1], b0[2], b0[3], b1[0], b1[1], b1[2], b1[3]};
        st.o[dh] = __builtin_amdgcn_mfma_f32_32x32x16_bf16(vf0, pf0, st.o[dh], 0, 0, 0);
        st.o[dh] = __builtin_amdgcn_mfma_f32_32x32x16_bf16(vf1, pf1, st.o[dh], 0, 0, 0);
    }
}
struct VFrags { s16x4 f[2][4]; };
__device__ __forceinline__ VFrags v_preload(const LAS unsigned char* vb) { VFrags v;
#pragma unroll
    for (int dh = 0; dh < 2; ++dh) { v.f[dh][0] = vtr(vb + dh * 64); v.f[dh][1] = vtr(vb + dh * 64 + 8 * VROW); v.f[dh][2] = vtr(vb + dh * 64 + 16 * VROW); v.f[dh][3] = vtr(vb + dh * 64 + 24 * VROW); }
    return v; }
__device__ __forceinline__ void pv_subtile_pre(AttnState& st, const VFrags& v, const f32x16& p) {
    u32x4 w0, w1; w0.x = cvtpk(p[0], p[1]); w0.y = cvtpk(p[2], p[3]); w0.z = cvtpk(p[4], p[5]); w0.w = cvtpk(p[6], p[7]);
    w1.x = cvtpk(p[8], p[9]); w1.y = cvtpk(p[10], p[11]); w1.z = cvtpk(p[12], p[13]); w1.w = cvtpk(p[14], p[15]);
    const bf16x8 pf0 = __builtin_bit_cast(bf16x8, w0), pf1 = __builtin_bit_cast(bf16x8, w1);
#pragma unroll
    for (int dh = 0; dh < 2; ++dh) {
        const s16x4 a0 = v.f[dh][0], a1 = v.f[dh][1], b0 = v.f[dh][2], b1 = v.f[dh][3];
        const bf16x8 vf0 = {a0[0], a0[1], a0[2], a0[3], a1[0], a1[1], a1[2], a1[3]}, vf1 = {b0[0], b0[1], b0[2], b0[3], b1[0], b1[1], b1[2], b1[3]};
        st.o[dh] = __builtin_amdgcn_mfma_f32_32x32x16_bf16(vf0, pf0, st.o[dh], 0, 0, 0);
        st.o[dh] = __builtin_amdgcn_mfma_f32_32x32x16_bf16(vf1, pf1, st.o[dh], 0, 0, 0);
    }
}
__device__ __forceinline__ void attn_tile(const LAS unsigned char* kb, const LAS unsigned char* vb, const bf16x8 (&q)[4], AttnState& st, bool rowok, int lo, int hi, int lane) {
    const int r32 = lane & 31, h = lane >> 5;
    const bool live = rowok && lo <= hi && hi >= 0 && lo <= 63;
    if (!__any(live)) return;
    const bool full = rowok && lo <= 0 && hi >= 63;
    const bool rowmask_only = __all(full || !live);
    const float cm = (rowmask_only && !full) ? -INFINITY : 0.f;
    f32x16 cinit;
#pragma unroll
    for (int r = 0; r < 16; ++r) cinit[r] = st.negm[r] + cm;
    const LAS unsigned char* kp = kb + r32 * KROW + h * 16;
    f32x16 s0, s1;
    { const bf16x8 k0 = *(const LAS bf16x8*)(kp), k1 = *(const LAS bf16x8*)(kp + 32 * KROW);
      s0 = __builtin_amdgcn_mfma_f32_32x32x16_bf16(k0, q[0], cinit, 0, 0, 0);
      s1 = __builtin_amdgcn_mfma_f32_32x32x16_bf16(k1, q[0], cinit, 0, 0, 0); }
#pragma unroll
    for (int ks = 1; ks < 4; ++ks) {
        const bf16x8 k0 = *(const LAS bf16x8*)(kp + ks * 32), k1 = *(const LAS bf16x8*)(kp + 32 * KROW + ks * 32);
        s0 = __builtin_amdgcn_mfma_f32_32x32x16_bf16(k0, q[ks], s0, 0, 0, 0);
        s1 = __builtin_amdgcn_mfma_f32_32x32x16_bf16(k1, q[ks], s1, 0, 0, 0);
    }
    const LAS unsigned char* vp = vb + (4 * h + ((lane & 15) >> 2)) * VROW + (16 * ((lane >> 4) & 1) + 4 * (lane & 3)) * 2;
    const VFrags vf0 = v_preload(vp);
    __builtin_amdgcn_sched_barrier(0);
    if (!rowmask_only) {
#pragma unroll
        for (int r = 0; r < 16; ++r) { const int kk = (r & 3) + 8 * (r >> 2) + 4 * h;
            if (!(live && kk >= lo && kk <= hi)) s0[r] = -INFINITY;
            if (!(live && kk + 32 >= lo && kk + 32 <= hi)) s1[r] = -INFINITY; }
    }
    float mx = fmaxf(fmaxf(s0[0], s1[0]), fmaxf(s0[1], s1[1]));
#pragma unroll
    for (int r = 2; r < 16; r += 2) mx = fmaxf(fmaxf(mx, s0[r]), fmaxf(s1[r], fmaxf(s0[r + 1], s1[r + 1])));
    mx = fmaxf(mx, swap32(mx));
    if (__any(mx > 8.0f)) {
        const float d = fmaxf(mx, 0.f), alpha = __builtin_amdgcn_exp2f(-d);
        st.m += d; st.l *= alpha;
#pragma unroll
        for (int r = 0; r < 16; ++r) { s0[r] -= d; s1[r] -= d; st.o[0][r] *= alpha; st.o[1][r] *= alpha; st.negm[r] = -st.m; }
    }
    float ls0 = 0.f, ls1 = 0.f;
#pragma unroll
    for (int r = 0; r < 16; ++r) { s0[r] = __builtin_amdgcn_exp2f(s0[r]); s1[r] = __builtin_amdgcn_exp2f(s1[r]); ls0 += s0[r]; ls1 += s1[r]; }
    st.l += ls0 + ls1;
    const VFrags vf1 = v_preload(vp + 32 * VROW);
    pv_subtile_pre(st, vf0, s0);
    pv_subtile_pre(st, vf1, s1);
}
template <bool FIRST>
__device__ __forceinline__ void attn_fold(LAS float* yl, const AttnState& st, float gate) {
    const float lt = st.l + swap32(st.l); const float f = lt > 0.f ? gate / lt : 0.f;
#pragma unroll
    for (int dh = 0; dh < 2; ++dh)
#pragma unroll
        for (int r = 0; r < 16; ++r) { float v = f * st.o[dh][r]; if (!FIRST) v += yl[(dh * 16 + r) * 512]; yl[(dh * 16 + r) * 512] = v; }
}
struct KVRegs { u32x4 k, v; };
__device__ __forceinline__ KVRegs kv_load(const unsigned char* Kg, const unsigned char* Vg, int tile, int tid) {
    KVRegs r; r.k = *(const u32x4*)(Kg + (size_t)tile * 8192 + tid * 16); r.v = *(const u32x4*)(Vg + (size_t)tile * 8192 + tid * 16); return r; }
__device__ __forceinline__ void kv_store(LAS unsigned char* lds, const KVRegs& r, int buf, int tid) {
    *(LAS u32x4*)(lds + L_K + buf * 64 * KROW + (tid >> 3) * KROW + (tid & 7) * 16) = r.k;
    *(LAS u32x4*)(lds + L_V + buf * 64 * VROW + (tid >> 3) * VROW + (tid & 7) * 16) = r.v; }
#define LDS_BAR() asm volatile("s_waitcnt lgkmcnt(0)\n\ts_barrier" ::: "memory")
template <class MF>
__device__ __forceinline__ void attn_pass(LAS unsigned char* lds, const unsigned char* Kg, const unsigned char* Vg, int t_lo, int t_hi, const bf16x8 (&q)[4], AttnState& st, const MF& mf, int tid, int lane) {
    const int n = t_hi - t_lo + 1;
    KVRegs rA = kv_load(Kg, Vg, t_lo, tid), rB = rA;
    if (n > 1) rB = kv_load(Kg, Vg, t_lo + 1, tid);
    for (int i = 0; i < n; i += 2) {
        kv_store(lds, rA, 0, tid);
        LDS_BAR();
        if (i + 2 < n) rA = kv_load(Kg, Vg, t_lo + i + 2, tid);
        { bool rowok; int lo, hi; mf(t_lo + i, rowok, lo, hi);
          attn_tile(lds + L_K, lds + L_V, q, st, rowok, lo, hi, lane); }
        if (i + 1 < n) {
            kv_store(lds, rB, 1, tid);
            LDS_BAR();
            if (i + 3 < n) rB = kv_load(Kg, Vg, t_lo + i + 3, tid);
            bool rowok; int lo, hi; mf(t_lo + i + 1, rowok, lo, hi);
            attn_tile(lds + L_K + 64 * KROW, lds + L_V + 64 * VROW, q, st, rowok, lo, hi, lane);
        }
    }
    __syncthreads();
}
__device__ __forceinline__ void store_y(bf16_t* dst, const f32x16 (&y)[2], int h) {
#pragma unroll
    for (int dh = 0; dh < 2; ++dh)
#pragma unroll
        for (int g4 = 0; g4 < 4; ++g4) *(u32x2*)(dst + 32 * dh + 8 * g4 + 4 * h) = (u32x2){cvtpk(y[dh][4 * g4], y[dh][4 * g4 + 1]), cvtpk(y[dh][4 * g4 + 2], y[dh][4 * g4 + 3])};
}

__device__ __forceinline__ void nsa_unit(const Args& a, LAS unsigned char* lds, int b, int g, int qc, int tid, int lane, int wave) {
    unsigned char* ws = a.ws;
    const int r32 = lane & 31, h = lane >> 5, hl = wave >> 1, head = g * 4 + hl, tt = 32 * (wave & 1) + r32, t = 64 * qc + tt;
    const size_t row = (size_t)b * SEQ + t; const int bg = b * 2 + g;
    bf16x8 q[4];
    { const bf16_t* qp = (const bf16_t*)(ws + WS_QN) + ((size_t)(b * 8 + head) * SEQ + t) * 64 + 8 * h;
#pragma unroll
      for (int ks = 0; ks < 4; ++ks) q[ks] = *(const bf16x8*)(qp + 16 * ks); }
    const float* gn = (const float*)(ws + WS_GN) + row * 32 + head * 3; const float g_c = gn[0], g_s = gn[1], g_w = gn[2];
    LAS float* yl = (LAS float*)(lds + L_Y) + tid;
    {
        const unsigned char* Kg = ws + WS_KCC + (size_t)bg * 128 * 128; const unsigned char* Vg = ws + WS_VCC + (size_t)bg * 128 * 128;
#pragma unroll
        for (int i = 0; i < 2; ++i) { const int idx = tid + 512 * i; const u32x4 kk = *(const u32x4*)(Kg + idx * 16), vv = *(const u32x4*)(Vg + idx * 16);
            *(LAS u32x4*)(lds + L_K + (idx >> 3) * KROW + (idx & 7) * 16) = kk; *(LAS u32x4*)(lds + L_V + (idx >> 3) * VROW + (idx & 7) * 16) = vv; }
        __syncthreads();
        const int cmax = t >= 31 ? ((t - 31) >> 4) : -1;
        f32x16 s[4];
        const LAS unsigned char* kp = lds + L_K + r32 * KROW + h * 16;
#pragma unroll
        for (int p = 0; p < 4; ++p) {
#pragma unroll
            for (int r = 0; r < 16; ++r) s[p][r] = 0.f;
#pragma unroll
            for (int ks = 0; ks < 4; ++ks) s[p] = __builtin_amdgcn_mfma_f32_32x32x16_bf16(*(const LAS bf16x8*)(kp + p * 32 * KROW + ks * 32), q[ks], s[p], 0, 0, 0);
        }
        float mx = -INFINITY;
#pragma unroll
        for (int p = 0; p < 4; ++p)
#pragma unroll
            for (int r = 0; r < 16; ++r) { const int c = 32 * p + (r & 3) + 8 * (r >> 2) + 4 * h; if (c > cmax) s[p][r] = -INFINITY; mx = fmaxf(mx, s[p][r]); }
        mx = fmaxf(mx, swap32(mx));
        const float msafe = (mx == -INFINITY) ? 0.f : mx; float ls = 0.f;
#pragma unroll
        for (int p = 0; p < 4; ++p)
#pragma unroll
            for (int r = 0; r < 16; ++r) { s[p][r] = __builtin_amdgcn_exp2f(s[p][r] - msafe); ls += s[p][r]; }
        ls += swap32(ls);
        const float inv = 1.0f / fmaxf(ls, 1e-30f);
#pragma unroll
        for (int p = 0; p < 4; ++p)
#pragma unroll
            for (int r = 0; r < 16; ++r) s[p][r] *= inv;
        LAS float* imp = (LAS float*)(lds + L_IMP) + (hl * 64 + tt) * 33;
        AttnState st; attn_reset(st);
        const LAS unsigned char* vp = lds + L_V + (4 * h + ((lane & 15) >> 2)) * VROW + (16 * ((lane >> 4) & 1) + 4 * (lane & 3)) * 2;
        float eprev = 0.f;
#pragma unroll
        for (int p = 0; p < 4; ++p) {
#pragma unroll
            for (int g4 = 0; g4 < 4; ++g4) {
                const float Gv = (s[p][4 * g4] + s[p][4 * g4 + 1]) + (s[p][4 * g4 + 2] + s[p][4 * g4 + 3]);
                const float esw = swap32(s[p][4 * g4 + 3]);
                imp[8 * p + 2 * g4 + h] = Gv + (h ? esw : eprev);
                eprev = esw;
            }
            pv_subtile(st, vp + p * 32 * VROW, s[p]);
        }
#pragma unroll
        for (int dh = 0; dh < 2; ++dh)
#pragma unroll
            for (int r = 0; r < 16; ++r) yl[(dh * 16 + r) * 512] = g_c * st.o[dh][r];
        __syncthreads();
        {
            const int tok = tid >> 3, sub = tid & 7, cur = qc; unsigned msk;
            if (cur - 2 <= 5) msk = (cur >= 31) ? 0xffffffffu : ((1u << (cur + 1)) - 1u);
            else {
                const LAS float* ip = (const LAS float*)(lds + L_IMP) + tok * 33 + sub * 4;
                float v4[4];
#pragma unroll
                for (int jj = 0; jj < 4; ++jj) { const int j = sub * 4 + jj; const float vj = ((ip[jj] + ip[64 * 33 + jj]) + ip[2 * 64 * 33 + jj]) + ip[3 * 64 * 33 + jj]; v4[jj] = (j >= 1 && j <= cur - 2) ? vj : -1.f; }
                msk = 1u | (1u << cur) | (1u << (cur - 1));
#pragma unroll
                for (int pick = 0; pick < 5; ++pick) {
                    float bv = v4[0]; int bj = sub * 4;
#pragma unroll
                    for (int jj = 1; jj < 4; ++jj) if (v4[jj] > bv) { bv = v4[jj]; bj = sub * 4 + jj; }
#pragma unroll
                    for (int off = 1; off < 8; off <<= 1) { const float ov = __shfl_xor(bv, off); const int oj = __shfl_xor(bj, off); if (ov > bv || (ov == bv && oj < bj)) { bv = ov; bj = oj; } }
                    msk |= 1u << bj;
#pragma unroll
                    for (int jj = 0; jj < 4; ++jj) if (sub * 4 + jj == bj) v4[jj] = -1.f;
                }
            }
            if (sub == 0) ((LAS unsigned*)(lds + L_SEL))[tok] = msk;
        }
        __syncthreads();
    }
    const unsigned selm = ((const LAS unsigned*)(lds + L_SEL))[tt];
    {
        AttnState st; attn_reset(st);
        auto mf = [&](int j, bool& rowok, int& lo, int& hi) { rowok = (selm >> j) & 1u; lo = 0; hi = (j == qc) ? tt : 63; };
        attn_pass(lds, ws + WS_KS + (size_t)bg * SEQ * 128, ws + WS_VS + (size_t)bg * SEQ * 128, 0, qc, q, st, mf, tid, lane);
        attn_fold<false>(yl, st, g_s);
    }
    {
        AttnState st; attn_reset(st);
        const int jl = qc - 8;
        auto mf = [&](int j, bool& rowok, int& lo, int& hi) { rowok = true; lo = (j == jl) ? tt + 1 : 0; hi = (j == qc) ? tt : 63; };
        attn_pass(lds, ws + WS_KW + (size_t)bg * SEQ * 128, ws + WS_VW + (size_t)bg * SEQ * 128, jl < 0 ? 0 : jl, qc, q, st, mf, tid, lane);
        attn_fold<false>(yl, st, g_w);
    }
    f32x16 y[2];
#pragma unroll
    for (int dh = 0; dh < 2; ++dh)
#pragma unroll
        for (int r = 0; r < 16; ++r) y[dh][r] = yl[(dh * 16 + r) * 512];
    store_y((bf16_t*)(ws + WS_YN) + row * 512 + head * 64, y, h);
}

__device__ __forceinline__ void moba_unit(const Args& a, LAS unsigned char* lds, int b, int hd, int own, int tid, int lane, int wave) {
    unsigned char* ws = a.ws;
    const int r32 = lane & 31, h = lane >> 5, tb = 32 * wave + r32, t = 256 * own + tb;
    const size_t row = (size_t)b * SEQ + t; const int bh = b * 8 + hd;
    bf16x8 q[4];
    { const bf16_t* qp = (const bf16_t*)(ws + WS_QM) + ((size_t)bh * SEQ + t) * 64 + 8 * h;
#pragma unroll
      for (int ks = 0; ks < 4; ++ks) q[ks] = *(const bf16x8*)(qp + 16 * ks); }
    unsigned msk;
    if (own <= 3) msk = (1u << own) - 1u;
    else {
        { const float* km = (const float*)(ws + WS_KMEAN) + (size_t)bh * 8 * 64; ((LAS float*)(lds + L_KMEAN))[tid] = km[tid]; }
        __syncthreads();
        float sc[7];
#pragma unroll
        for (int n = 0; n < 7; ++n) { float d = 0.f;
            if (n < own) {
                const LAS float* kmn = (const LAS float*)(lds + L_KMEAN) + n * 64 + 8 * h;
#pragma unroll
                for (int ks = 0; ks < 4; ++ks)
#pragma unroll
                    for (int j = 0; j < 8; ++j) d += bf2f((unsigned short)q[ks][j]) * kmn[16 * ks + j];
                d += swap32(d);
            }
            sc[n] = d; }
        msk = 0u;
        for (int pick = 0; pick < 3; ++pick) { int best = 0; float bv = -INFINITY;
#pragma unroll
            for (int n = 0; n < 7; ++n) if (n < own && !((msk >> n) & 1u) && sc[n] > bv) { bv = sc[n]; best = n; }
            msk |= 1u << best; }
        __syncthreads();
    }
    AttnState st; attn_reset(st);
    auto mf = [&](int kt, bool& rowok, int& lo, int& hi) { const int n = kt >> 2; lo = 0;
        if (n < own) { rowok = (msk >> n) & 1u; hi = 63; } else { rowok = true; const int d = tb - 64 * (kt & 3); hi = d > 63 ? 63 : d; } };
    attn_pass(lds, ws + WS_KM + (size_t)bh * SEQ * 128, ws + WS_VM + (size_t)bh * SEQ * 128, 0, 4 * own + 3, q, st, mf, tid, lane);
    { const float lt = st.l + swap32(st.l); const float f = lt > 0.f ? 1.0f / lt : 0.f;
#pragma unroll
      for (int r = 0; r < 16; ++r) { st.o[0][r] *= f; st.o[1][r] *= f; } }
    store_y((bf16_t*)(ws + WS_YM) + row * 512 + hd * 64, st.o, h);
}

__device__ __forceinline__ bool decode_unit(int u, int& type, int& par, int& sub) {
    if (u < 1024) { type = 1; par = 7 - (u >> 7); sub = u & 127; return true; }
    u -= 1024;
    if (u < 1024) { type = 0; par = 31 - (u >> 5); sub = u & 31; return true; }
    return false;
}
__device__ __forceinline__ void attention_phase(const Args& a, LAS unsigned char* lds, int tid, int lane, int wave, int rep) {
    unsigned* ctr = (unsigned*)(a.ws + WS_CTL) + rep;
    unsigned* cflag = (unsigned*)(a.ws + WS_CTL) + 16 + rep;
    if (blockIdx.x < 32) {
        unsigned char* ws = a.ws;
        { SchedCmp S{(const char*)(ws + WS_KC), (const char*)(ws + WS_VC), (const char*)(ws + WS_WCK1), (const char*)(ws + WS_WCV1), (size_t)256 * 1024 * 2};
          EpiCmp1 E{(const float*)(ws + WS_B1), (bf16_t*)(ws + WS_HID)};
          pg8::gemm_phase(lds, 2048, 1024, 2048, S, E); }
        asm volatile("s_waitcnt vmcnt(0)" ::: "memory"); __builtin_amdgcn_fence(__ATOMIC_RELEASE, "agent"); __syncthreads(); __builtin_amdgcn_fence(__ATOMIC_ACQUIRE, "agent");
        { SchedCmp S{(const char*)(ws + WS_HID), (const char*)(ws + WS_HID) + (size_t)4096 * 256 * 2, (const char*)(ws + WS_WCK2), (const char*)(ws + WS_WCV2), (size_t)256 * 256 * 2};
          EpiCmp2 E{a.in[6], (const float*)(ws + WS_ROPE), (bf16_t*)(ws + WS_KCC), (bf16_t*)(ws + WS_VCC)};
          pg8::gemm_phase(lds, 256, 256, 256, S, E); }
        asm volatile("s_waitcnt vmcnt(0)" ::: "memory"); __builtin_amdgcn_fence(__ATOMIC_RELEASE, "agent"); __syncthreads();
        if (tid == 0) __hip_atomic_fetch_add(cflag, 1u, __ATOMIC_RELEASE, __HIP_MEMORY_SCOPE_AGENT);
    }
    bool cmp_ready = false;
    unsigned unext = 0u;
    if (tid == 0) unext = atomicAdd(ctr, 1u);
    for (;;) {
        if (tid == 0) ((LAS unsigned*)(lds + L_Q))[0] = unext;
        __syncthreads();
        const int u = (int)((LAS unsigned*)(lds + L_Q))[0];
        __syncthreads();
        int type, par, sub;
        if (!decode_unit(u, type, par, sub)) break;
        if (tid == 0) unext = atomicAdd(ctr, 1u);
        if (type == 0 && !cmp_ready) {
            if (tid == 0) { unsigned sp = 0; while (__hip_atomic_load(cflag, __ATOMIC_RELAXED, __HIP_MEMORY_SCOPE_AGENT) < 32u) { __builtin_amdgcn_s_sleep(8); if (++sp > (1u << 22)) break; } }
            __syncthreads(); __builtin_amdgcn_fence(__ATOMIC_ACQUIRE, "agent"); cmp_ready = true;
        }
        if (type == 0) nsa_unit(a, lds, sub >> 1, sub & 1, par, tid, lane, wave);
        else moba_unit(a, lds, sub >> 3, sub & 7, par, tid, lane, wave);
    }
}

#define XB_TMO      128
#define XB_XCNT(j)  (256  + 64 * (j))
#define XB_XSUB(j)  (1280 + 64 * (j))
#define XB_XGEN(j)  (2304 + 64 * (j))
#define XB_TOP      3328
#define XB_TOPGEN   3392
#define XCD_BAR_WORDS 3456
#define XB_SPIN_CAP (1u << 18)
__device__ __forceinline__ unsigned xb_ld(unsigned* p)              { return __hip_atomic_load(p, __ATOMIC_RELAXED, __HIP_MEMORY_SCOPE_AGENT); }
__device__ __forceinline__ unsigned xb_add(unsigned* p, unsigned v) { return __hip_atomic_fetch_add(p, v, __ATOMIC_RELAXED, __HIP_MEMORY_SCOPE_AGENT); }
__device__ __forceinline__ unsigned xb_xcc_id() { return (unsigned)__builtin_amdgcn_s_getreg((3 << 11) | 20) & 0xFu; }
#define XB_SPIN(cond, bar) do { unsigned _sp = 0; while (cond) { __builtin_amdgcn_s_sleep(1); \
    if ((++_sp & 255u) == 0u) { if (xb_ld(&(bar)[XB_TMO])) break; if (_sp > XB_SPIN_CAP) { atomicAdd(&(bar)[XB_TMO], 1u); break; } } } } while (0)
struct XcdBarrier { unsigned* bar; unsigned x; volatile LAS unsigned* st; };
__device__ __forceinline__ XcdBarrier xcd_barrier_post(unsigned* bar, volatile LAS unsigned* st) {
    XcdBarrier b; b.bar = bar; b.x = xb_xcc_id(); b.st = st;
    if (threadIdx.x == 0) (void)xb_add(&bar[XB_XCNT(b.x)], 1u);
    return b;
}
__device__ __forceinline__ void xcd_barrier_complete(unsigned* bar, unsigned x, unsigned& nloc, unsigned& nx) {
    const unsigned G = gridDim.x * gridDim.y * gridDim.z;
    unsigned sum, cnt, mine, sp = 0u;
    for (;;) {
        sum = 0u; cnt = 0u; mine = 0u;
#pragma unroll
        for (unsigned j = 0; j < 16; ++j) { const unsigned c = xb_ld(&bar[XB_XCNT(j)]); sum += c; cnt += (c > 0u) ? 1u : 0u; mine = (j == x) ? c : mine; }
        if (sum == G) break;
        __builtin_amdgcn_s_sleep(1);
        if ((++sp & 255u) == 0u) { if (xb_ld(&bar[XB_TMO])) break; if (sp > XB_SPIN_CAP) { atomicAdd(&bar[XB_TMO], 1u); break; } }
    }
    nloc = mine > 0u ? mine : 1u; nx = cnt > 0u ? cnt : 1u;
}
__device__ __forceinline__ void xcd_barrier(const XcdBarrier& b) {
    asm volatile("s_waitcnt vmcnt(0)" ::: "memory");
    __syncthreads();
    if (threadIdx.x == 0) {
        unsigned* bar = b.bar;
        __builtin_amdgcn_s_waitcnt(0);
        unsigned nloc = b.st[0], nx = b.st[1];
        if (nloc == 0u) { xcd_barrier_complete(bar, b.x, nloc, nx); b.st[0] = nloc; b.st[1] = nx; }
        const unsigned old = xb_add(&bar[XB_XSUB(b.x)], 1u);
        const unsigned gen = old / nloc;
        if (old + 1u == (gen + 1u) * nloc) {
            __builtin_amdgcn_fence(__ATOMIC_RELEASE, "agent");
            asm volatile("s_waitcnt vmcnt(0)" ::: "memory");
            const unsigned og = xb_add(&bar[XB_TOP], 1u);
            const unsigned tg = og / nx;
            if (og + 1u == (tg + 1u) * nx) xb_add(&bar[XB_TOPGEN], 1u);
            else XB_SPIN(xb_ld(&bar[XB_TOPGEN]) == tg, bar);
            __builtin_amdgcn_fence(__ATOMIC_ACQUIRE, "agent");
            xb_add(&bar[XB_XGEN(b.x)], 1u);
            asm volatile("s_waitcnt vmcnt(0)" ::: "memory");
        } else {
            XB_SPIN(xb_ld(&bar[XB_XGEN(b.x)]) == gen, bar);
            __builtin_amdgcn_fence(__ATOMIC_ACQUIRE, "agent");
            asm volatile("s_waitcnt vmcnt(0)" ::: "memory");
        }
    }
    __syncthreads();
}

constexpr int NPHASE = 10;
constexpr int LDS_BYTES = 147456, L_MISC = LDS_BYTES - 64;
constexpr int CW_BAR = 1024;
constexpr size_t CTL_ZERO_BYTES = 32768;
__global__ void __launch_bounds__(512) fwd_kernel(Args a) {
    extern __shared__ __attribute__((aligned(16))) unsigned char lds_raw[];
    LAS unsigned char* lds = (LAS unsigned char*)lds_raw;
    const int tid = threadIdx.x, lane = tid & 63, wave = __builtin_amdgcn_readfirstlane(tid >> 6);
    unsigned char* ws = a.ws;
    const int lo = a.ph_lo, hi = a.ph_hi;
#ifndef PH_MASK
#define PH_MASK 0x3ff
#endif
#define IN(k) (((PH_MASK >> (k)) & 1) && lo <= (k) && (k) < hi)
#define SEAM(k) do { if (IN(k) && IN((k) + ((k) == 2 ? 2 : 1))) { xcd_barrier(bar); } } while (0)
    volatile LAS unsigned* misc = (volatile LAS unsigned*)(lds + L_MISC);
    if (tid < 16) misc[tid] = 0u;
    __syncthreads();
    XcdBarrier bar = xcd_barrier_post((unsigned*)(ws + WS_CTL) + CW_BAR, misc);
    if (lo < 0) cg::this_grid().sync();
    if (IN(0)) { p0_prologue(a, lds, tid, lane, wave); }
    SEAM(0);
    if (IN(1)) {
        if (blockIdx.x == 0) { const float* pb = (const float*)(ws + WS_PBIAS); float s = 0.f; const int kv = tid >> 8, n = tid & 255;
            for (int c = 0; c < 32; ++c) s += pb[(size_t)(kv * 32 + c) * 256 + n];
            ((float*)(ws + WS_B1))[tid] = s; }
        SchedStd S; S.init(ws + WS_XB, DM, ws + WS_WIN, DM, T, IN_PAD, NREP(1));
        EpiProj E{(const float*)(ws + WS_RSTD0), (const float*)(ws + WS_ROPE), a.in[5], a.in[7], a.in[8], a.in[15], a.in[16],
                  (bf16_t*)(ws + WS_QN), (bf16_t*)(ws + WS_KC), (bf16_t*)(ws + WS_VC), (bf16_t*)(ws + WS_KS), (bf16_t*)(ws + WS_VS), (bf16_t*)(ws + WS_KW), (bf16_t*)(ws + WS_VW),
                  (bf16_t*)(ws + WS_QM), (bf16_t*)(ws + WS_KM), (bf16_t*)(ws + WS_VM), (bf16_t*)(ws + WS_GA), (bf16_t*)(ws + WS_GB), (float*)(ws + WS_GN)};
        pg8::gemm_phase(lds, DM, DM, DM, S, E);
    }
    SEAM(1);
    if (IN(2)) {
        kmean_phase(a, lane, wave);
        SchedStd S; S.init(ws + WS_PB, PLE, ws + WS_WPP, PLE, T, DM); EpiStoreBf16 E{(bf16_t*)(ws + WS_PP)}; pg8::gemm_phase(lds, PLE, PLE, PLE, S, E);
    }
    SEAM(2);
    if (IN(4)) { for (int rep = 0; rep < NREP(4); ++rep) attention_phase(a, lds, tid, lane, wave, rep); }
    SEAM(4);
    if (IN(5)) {
        SchedMerge S; S.init(ws + WS_YN, ws + WS_YM, ws + WS_WUPN, ws + WS_WUPM, 512, T, DM);
        EpiMerge E{(const bf16_t*)(ws + WS_GA), (const bf16_t*)(ws + WS_GB), (bf16_t*)(ws + WS_MB)};
        pg8::gemm_phase(lds, 512, 512, 512, S, E);
    }
    SEAM(5);
    if (IN(6)) {
        SchedStd S; S.init(ws + WS_MB, DM, ws + WS_WOUT, DM, T, DM);
        EpiResid<true> E{a.in[0], (bf16_t*)(ws + WS_XB), (float*)(ws + WS_RSSP)};
        pg8::gemm_phase(lds, DM, DM, DM, S, E);
    }
    SEAM(6);
    if (IN(7)) {
        SchedStd S; S.init(ws + WS_XB, DM, ws + WS_WFFI, DM, T, 2 * DFF, NREP(7));
        EpiFfnIn E{(const float*)(ws + WS_RSSP), (bf16_t*)(ws + WS_HB)};
        pg8::gemm_phase(lds, DM, DM, DM, S, E);
    }
    SEAM(7);
    if (IN(8)) {
        SchedStd S; S.init(ws + WS_HB, DFF, ws + WS_WFFO, DFF, T, DM);
        EpiResid<false> E{nullptr, (bf16_t*)(ws + WS_XB), (float*)(ws + WS_RSSP)};
        pg8::gemm_phase(lds, DFF, DFF, DFF, S, E);
    }
    SEAM(8);
    if (IN(9)) {
#ifndef NO_P9B
        { SchedStd S; S.init(ws + WS_XB, DM, ws + WS_WPG, DM, T, DM); EpiPle E{(const float*)(ws + WS_RSSP), (const bf16_t*)(ws + WS_PP), (const bf16_t*)(ws + WS_XB), a.out}; pg8::gemm_phase(lds, DM, DM, DM, S, E); }
#endif
    }
#undef IN
#undef SEAM
}

extern "C" void kernel_launch(void* const* d_in, const int* in_sizes, int n_in, void* d_out, int out_size, void* d_ws, size_t ws_size, hipStream_t stream) {
    static int grid = 0;
    if (grid == 0) {
        if (n_in != 26 || out_size != T * DM || ws_size < WS_END) { fprintf(stderr, "kernel_launch: unexpected shapes (n_in %d, out %d, ws %zu)\n", n_in, out_size, ws_size); grid = -1; return; }
        int dev = 0, cus = 0, per_cu = 0;
        hipGetDevice(&dev); hipDeviceGetAttribute(&cus, hipDeviceAttributeMultiprocessorCount, dev);
        if (hipFuncSetAttribute((const void*)fwd_kernel, hipFuncAttributeMaxDynamicSharedMemorySize, LDS_BYTES) != hipSuccess) { fprintf(stderr, "kernel_launch: hipFuncSetAttribute failed\n"); grid = -1; return; }
        if (hipOccupancyMaxActiveBlocksPerMultiprocessor(&per_cu, (const void*)fwd_kernel, 512, LDS_BYTES) != hipSuccess || per_cu < 1) { fprintf(stderr, "kernel_launch: occupancy query gave %d\n", per_cu); per_cu = 1; }
        (void)hipGetLastError();
        grid = cus * 1;
    }
    if (grid < 0) return;
    if (hipMemsetAsync((char*)d_ws + WS_CTL, 0, CTL_ZERO_BYTES, stream) != hipSuccess) { fprintf(stderr, "kernel_launch: memset failed\n"); return; }
    Args a{};
    for (int i = 0; i < 26; ++i) a.in[i] = (const float*)d_in[i];
    a.pos = (const int*)d_in[2]; a.out = (float*)d_out; a.ws = (unsigned char*)d_ws;
    for (int j = 0; j < 8; ++j) a.inv_freq[j] = powf(500000.0f, -(float)j / 8.0f);
#if MK_PER_PHASE
    for (int ph = 0; ph < NPHASE; ++ph) { a.ph_lo = ph; a.ph_hi = ph + 1; hipLaunchKernelGGL(fwd_kernel, dim3(grid), dim3(512), LDS_BYTES, stream, a); }
#else
    a.ph_lo = 0; a.ph_hi = NPHASE;
    void* args[] = {&a};
    hipError_t e = hipLaunchCooperativeKernel((const void*)fwd_kernel, dim3(grid), dim3(512), args, LDS_BYTES, stream);
    if (e != hipSuccess) fprintf(stderr, "cooperative launch failed: %s (grid %d)\n", hipGetErrorString(e), grid);
#endif
}
```

```cpp
#include <hip/hip_runtime.h>
#include <hip/hip_cooperative_groups.h>
#include <cstdio>
#include <cstdint>
#include <cmath>
namespace cg = cooperative_groups;

#ifndef MK_PER_PHASE
#define MK_PER_PHASE 0
#endif

#ifndef REPEAT_PHASE
#define REPEAT_PHASE 0
#endif
#define NREP(k) ((((REPEAT_PHASE) >> (k)) & 1) ? 2 : 1)
#define LAS __attribute__((address_space(3)))
typedef unsigned short bf16_t;
typedef short bf16x8 __attribute__((ext_vector_type(8)));
typedef short s16x4 __attribute__((ext_vector_type(4)));
typedef float f32x4 __attribute__((ext_vector_type(4)));
typedef float f32x16 __attribute__((ext_vector_type(16)));
typedef unsigned u32x4 __attribute__((ext_vector_type(4)));
typedef unsigned u32x2 __attribute__((ext_vector_type(2)));
typedef float f32x2_t __attribute__((ext_vector_type(2)));
typedef __bf16 bf16x2_t __attribute__((ext_vector_type(2)));

__device__ __forceinline__ unsigned cvtpk(float lo, float hi) { f32x2_t v = {lo, hi}; bf16x2_t b = __builtin_convertvector(v, bf16x2_t); return __builtin_bit_cast(unsigned, b); }
__device__ __forceinline__ float swap32(float v) { auto rr = __builtin_amdgcn_permlane32_swap(__builtin_bit_cast(unsigned, v), __builtin_bit_cast(unsigned, v), false, false); return __builtin_bit_cast(float, (threadIdx.x & 32) ? rr[0] : rr[1]); }
__device__ __forceinline__ float bf2f(unsigned short b) { return __builtin_bit_cast(float, (unsigned)b << 16); }
__device__ __forceinline__ float sigmoidf_(float x) { return __builtin_amdgcn_rcpf(1.0f + __builtin_amdgcn_exp2f(-1.4426950408889634f * x)); }

constexpr int DM = 1024, NB = 16, SEQ = 2048, T = NB * SEQ;
constexpr int HD = 64, NSA_H = 8, NSA_G = 2, MOBA_H = 8;
constexpr int NCMP = 127, NCMP_PAD = 128;
constexpr int DFF = 2816, PLE = 256, IN_COLS = 4888, IN_PAD = 5120;
constexpr float EPS = 1e-6f;
constexpr float C2 = 0.125f * 1.4426950408889634f;

constexpr size_t MiB = 1u << 20;
constexpr size_t WS_CTL = 0;
constexpr size_t WS_WIN = 1 * MiB, WS_WFFI = 11 * MiB, WS_WFFO = 22 * MiB, WS_WOUT = 28 * MiB, WS_WPG = 30 * MiB, WS_WUPN = 32 * MiB, WS_WUPM = 33 * MiB,
                 WS_WPP = 34 * MiB, WS_WCK1 = 35 * MiB, WS_WCV1 = 36 * MiB, WS_WCK2 = 37 * MiB, WS_WCV2 = 37 * MiB + 256 * 1024;
constexpr size_t WS_RSTD0 = 38 * MiB, WS_PBIAS = 38 * MiB + 256 * 1024, WS_B1 = 38 * MiB + 512 * 1024, WS_KMEAN = 39 * MiB, WS_KCC = 40 * MiB, WS_VCC = 41 * MiB,
                 WS_HID = 42 * MiB, WS_ROPE = 46 * MiB, WS_RSSP = 48 * MiB, WS_GN = 50 * MiB, WS_PB = 54 * MiB;
constexpr size_t WS_XB = 72 * MiB;
constexpr size_t WS_YN = 72 * MiB, WS_YM = 104 * MiB;
constexpr size_t WS_QN = 136 * MiB, WS_QM = 168 * MiB, WS_KM = 200 * MiB, WS_VM = 232 * MiB,
                 WS_KC = 264 * MiB, WS_VC = 272 * MiB, WS_KS = 280 * MiB, WS_VS = 288 * MiB, WS_KW = 296 * MiB, WS_VW = 304 * MiB;
constexpr size_t WS_MB = 136 * MiB, WS_HB = 136 * MiB;
constexpr size_t WS_GA = 312 * MiB, WS_GB = 376 * MiB, WS_PP = 440 * MiB, WS_END = 504 * MiB;

namespace pg8 {
constexpr int BM = 256, BK = 64, HALF = 128, HTB = HALF * BK * 2, STAGE_BYTES = 8 * HTB, NXCD = 8, WGM = 8;
__host__ __device__ __forceinline__ int lds_byte(int r, int c) { const int st = (r >> 4) * 2 + (c >> 5), rr = r & 15, cc = c & 31, ob = rr * 64 + cc * 2; return st * 1024 + (ob ^ (((ob >> 9) & 1) << 5)); }
__host__ __device__ __forceinline__ void stage_rc(int b, int& R, int& C) { const int st = b / 1024, sb = b % 1024, swz = sb ^ (((sb >> 9) & 1) << 5); R = (st >> 1) * 16 + swz / 64; C = (st & 1) * 32 + (swz % 64) / 2; }

struct Unit { int pm, pn, aux; const char* A; const char* B; };
struct StaticOrder {
    int nM, nN, nwg, G, c;
    __host__ __device__ void init(int M, int N, int G_, int c_) { nM = M / BM; nN = N / BM; nwg = nM * nN; G = G_; c = c_; }
    __host__ __device__ bool next(int i, int& pm, int& pn) const {
        const long L = (long)i * G + c; if (L >= nwg) return false;
        int wgid = (int)L; { const int q = nwg / NXCD, r = nwg % NXCD, xcd = wgid % NXCD, off = wgid / NXCD; wgid = (xcd < r ? xcd * (q + 1) : r * (q + 1) + (xcd - r) * q) + off; }
        const int nig = WGM * nN, gid = wgid / nig, fm = gid * WGM, gsz = (nM - fm) < WGM ? (nM - fm) : WGM;
        pm = fm + ((wgid % nig) % gsz); pn = (wgid % nig) / gsz; return true;
    }
};

template <class Epi, class Sched>
__device__ __forceinline__ void gemm_phase(LAS unsigned char* lds, const int K_in, const int lda, const int ldb, const Sched& S, const Epi& E) {
    int K = K_in; asm volatile("" : "+s"(K));
    const int tid = threadIdx.x, wid = __builtin_amdgcn_readfirstlane(tid >> 6), lane = tid & 63, wr = wid >> 2, wc = wid & 3, fr = lane & 15, fq = lane >> 4;
    const int nt = K / BK;
    unsigned voffA[2], voffB[2];
#pragma unroll
    for (int i = 0; i < 2; ++i) { int R, C; stage_rc(tid * 16 + i * 8192, R, C); voffA[i] = (unsigned)(R * lda + C) * 2u; voffB[i] = (unsigned)(R * ldb + C) * 2u; }
    const size_t kstep = (size_t)(BK * 2);
    const size_t hstepA = (size_t)HALF * lda * 2, hstepB = (size_t)HALF * ldb * 2;
    const unsigned ldsw = (unsigned)wid * 1024u;
    const int aoff = lds_byte(wr * 64 + fr, fq * 8), boff = lds_byte(wc * 32 + fr, fq * 8);
#define PG8_SA(b, h) (((b) * 2 + (h)) * HTB)
#define PG8_SB(b, h) ((4 + (b) * 2 + (h)) * HTB)
#define PG8_STAGE(bufoff, gbase, voff) do { _Pragma("unroll") for (int _i = 0; _i < 2; ++_i) \
        __builtin_amdgcn_global_load_lds((const unsigned*)((const char*)(gbase) + (voff)[_i]), (LAS unsigned*)(lds + (bufoff) + ldsw + _i * 8192), 16, 0, 0); } while (0)
#define PG8_LDA(dst, b, h) do { _Pragma("unroll") for (int m = 0; m < 4; ++m) _Pragma("unroll") for (int k = 0; k < 2; ++k) dst[m][k] = *(const LAS bf16x8*)(lds + PG8_SA(b, h) + aoff + m * 2048 + k * 1024); } while (0)
#define PG8_LDB(dst, b, h) do { _Pragma("unroll") for (int n = 0; n < 2; ++n) _Pragma("unroll") for (int k = 0; k < 2; ++k) dst[n][k] = *(const LAS bf16x8*)(lds + PG8_SB(b, h) + boff + n * 2048 + k * 1024); } while (0)
#define PG8_MMA(ai, bj, At, Bt) do { __builtin_amdgcn_s_setprio(1); _Pragma("unroll") for (int m = 0; m < 4; ++m) _Pragma("unroll") for (int n = 0; n < 2; ++n) _Pragma("unroll") for (int k = 0; k < 2; ++k) \
        acc[ai][bj][m][n] = __builtin_amdgcn_mfma_f32_16x16x32_bf16(Bt[n][k], At[m][k], acc[ai][bj][m][n], 0, 0, 0); __builtin_amdgcn_s_setprio(0); } while (0)
#define PG8_WAIT_V(n) asm volatile("s_waitcnt vmcnt(" #n ")" ::: "memory")
#define PG8_WAIT_L(n) asm volatile("s_waitcnt lgkmcnt(" #n ")" ::: "memory")
#define PG8_BAR __builtin_amdgcn_s_barrier()
#define PG8_SCHED __builtin_amdgcn_sched_barrier(0)
    Unit cur, nxt; int ui = 0;
    if (!S.next(0, cur)) return;
    f32x4 acc[2][2][4][2];
#pragma unroll
    for (int a = 0; a < 2; ++a)
#pragma unroll
        for (int b = 0; b < 2; ++b)
#pragma unroll
            for (int m = 0; m < 4; ++m)
#pragma unroll
                for (int n = 0; n < 2; ++n) acc[a][b][m][n] = (f32x4){0.f, 0.f, 0.f, 0.f};
    bf16x8 At[4][2], B0[2][2], B1[2][2];
    const char* cA = cur.A; const char* cB = cur.B;
    PG8_STAGE(PG8_SB(0, 0), cB, voffB); PG8_STAGE(PG8_SB(0, 1), cB + hstepB, voffB); PG8_STAGE(PG8_SA(0, 0), cA, voffA); PG8_STAGE(PG8_SA(0, 1), cA + hstepA, voffA);
    if (wr == 1) PG8_BAR;
    PG8_WAIT_V(2); PG8_BAR;
    PG8_STAGE(PG8_SB(1, 0), cB + kstep, voffB); PG8_STAGE(PG8_SA(1, 0), cA + kstep, voffA); PG8_STAGE(PG8_SB(1, 1), cB + hstepB + kstep, voffB);
    PG8_WAIT_V(6); PG8_BAR;
    for (;;) {
        const bool has_next = S.next(ui + 1, nxt);
        const char* nA = has_next ? nxt.A : cA; const char* nB = has_next ? nxt.B : cB;
        for (int t = 0; t < nt; t += 2) {
            const bool last = (t == nt - 2);
            const char* a1 = cA + (size_t)(t + 1) * kstep;
            const char* a2 = last ? nA : cA + (size_t)(t + 2) * kstep; const char* b2 = last ? nB : cB + (size_t)(t + 2) * kstep;
            const char* a3 = a2 + kstep; const char* b3 = b2 + kstep;
            PG8_LDB(B0, 0, 0); PG8_LDB(B1, 0, 1); PG8_SCHED; PG8_LDA(At, 0, 0); PG8_STAGE(PG8_SA(1, 1), a1 + hstepA, voffA);
            PG8_WAIT_V(8); PG8_WAIT_L(0); PG8_BAR; PG8_MMA(0, 0, At, B0); PG8_MMA(0, 1, At, B1); PG8_BAR; PG8_SCHED;
            PG8_LDA(At, 0, 1); PG8_STAGE(PG8_SB(0, 0), b2, voffB); PG8_STAGE(PG8_SB(0, 1), b2 + hstepB, voffB); PG8_STAGE(PG8_SA(0, 0), a2, voffA);
            PG8_WAIT_V(8); PG8_WAIT_L(0); PG8_BAR; PG8_MMA(1, 0, At, B0); PG8_MMA(1, 1, At, B1); PG8_BAR; PG8_SCHED;
            PG8_LDB(B0, 1, 0); PG8_LDB(B1, 1, 1); PG8_SCHED; PG8_LDA(At, 1, 0); PG8_STAGE(PG8_SA(0, 1), a2 + hstepA, voffA);
            PG8_WAIT_V(8); PG8_WAIT_L(0); PG8_BAR; PG8_MMA(0, 0, At, B0); PG8_MMA(0, 1, At, B1); PG8_BAR; PG8_SCHED;
            PG8_LDA(At, 1, 1); PG8_STAGE(PG8_SB(1, 0), b3, voffB); PG8_STAGE(PG8_SB(1, 1), b3 + hstepB, voffB); PG8_STAGE(PG8_SA(1, 0), a3, voffA);
            PG8_WAIT_V(8); PG8_WAIT_L(0); PG8_BAR; PG8_MMA(1, 0, At, B0); PG8_MMA(1, 1, At, B1); PG8_BAR; PG8_SCHED;
        }
        if (wr == 0) PG8_BAR;
        E(acc, cur, wr, wc, fr, fq);
        if (!has_next) break;
#pragma unroll
        for (int a = 0; a < 2; ++a)
#pragma unroll
            for (int b = 0; b < 2; ++b)
#pragma unroll
                for (int m = 0; m < 4; ++m)
#pragma unroll
                    for (int n = 0; n < 2; ++n) acc[a][b][m][n] = (f32x4){0.f, 0.f, 0.f, 0.f};
        cur = nxt; cA = nA; cB = nB; ++ui;
        if (wr == 1) PG8_BAR;
    }
    PG8_WAIT_V(0);
    PG8_BAR;
#undef PG8_SA
#undef PG8_SB
#undef PG8_STAGE
#undef PG8_LDA
#undef PG8_LDB
#undef PG8_MMA
#undef PG8_WAIT_V
#undef PG8_WAIT_L
#undef PG8_BAR
#undef PG8_SCHED
}
}
using pg8::Unit;
typedef f32x4 Acc[2][2][4][2];

__host__ __device__ __forceinline__ int phys_col(int L) { const int tile = L >> 8, l = L & 255, wc = l >> 6, fq = (l >> 4) & 3, bj = (l >> 3) & 1, n = (l >> 2) & 1, i = l & 3; return tile * 256 + 128 * bj + 32 * wc + 16 * n + 4 * fq + i; }

struct SchedStd {
    pg8::StaticOrder so; const char* A; const char* B; size_t a_tile, b_tile; int nmine, reps;
    __device__ __forceinline__ void init(const void* A_, int lda, const void* B_, int ldb, int M, int N, int reps_ = 1) { so.init(M, N, (int)gridDim.x, (int)blockIdx.x); A = (const char*)A_; B = (const char*)B_; a_tile = (size_t)256 * lda * 2; b_tile = (size_t)256 * ldb * 2;
        nmine = so.nwg > so.c ? (so.nwg - so.c + so.G - 1) / so.G : 0; reps = reps_; }
    __device__ __forceinline__ bool next(int i, Unit& u) const { int pm, pn; if (i >= nmine * reps) return false; so.next(i % nmine, pm, pn); u.pm = pm; u.pn = pn; u.aux = 0; u.A = A + (size_t)pm * a_tile; u.B = B + (size_t)pn * b_tile; return true; }
};
struct SchedMerge {
    pg8::StaticOrder so; const char* A0; const char* A1; const char* B0; const char* B1; size_t a_tile, b_tile; int nmine;
    __device__ __forceinline__ void init(const void* A0_, const void* A1_, const void* B0_, const void* B1_, int ld, int M, int N) { so.init(M, N, (int)gridDim.x, (int)blockIdx.x);
        A0 = (const char*)A0_; A1 = (const char*)A1_; B0 = (const char*)B0_; B1 = (const char*)B1_; a_tile = (size_t)256 * ld * 2; b_tile = (size_t)256 * ld * 2;
        nmine = so.nwg > so.c ? (so.nwg - so.c + so.G - 1) / so.G : 0; }
    __device__ __forceinline__ bool next(int i, Unit& u) const { int pm, pn; if (i >= 2 * nmine) return false; so.next(i >> 1, pm, pn); u.pm = pm; u.pn = pn; u.aux = i & 1;
        u.A = ((i & 1) ? A1 : A0) + (size_t)pm * a_tile; u.B = ((i & 1) ? B1 : B0) + (size_t)pn * b_tile; return true; }
};
struct SchedCmp {
    const char* A0; const char* A1; const char* B0; const char* B1; size_t a_tile;
    __device__ __forceinline__ bool next(int i, Unit& u) const { const int c = (int)blockIdx.x; if (i >= NREP(2) || c >= 32) return false; u.aux = c >> 4; u.pm = c & 15; u.pn = 0; u.A = (u.aux ? A1 : A0) + (size_t)u.pm * a_tile; u.B = u.aux ? B1 : B0; return true; }
};

#define EPI_ROWS_BEGIN _Pragma("unroll") for (int ai = 0; ai < 2; ++ai) _Pragma("unroll") for (int m = 0; m < 4; ++m) { const int row = u.pm * 256 + ai * 128 + wr * 64 + m * 16 + fr; float v[16]; \
    _Pragma("unroll") for (int bj = 0; bj < 2; ++bj) _Pragma("unroll") for (int n = 0; n < 2; ++n) _Pragma("unroll") for (int i = 0; i < 4; ++i) v[8 * bj + 4 * n + i] = acc[ai][bj][m][n][i];
#define EPI_ROWS_END }
__device__ __forceinline__ void store_bf16x16(bf16_t* dst, const float (&v)[16]) {
    u32x4 a, b; a.x = cvtpk(v[0], v[1]); a.y = cvtpk(v[2], v[3]); a.z = cvtpk(v[4], v[5]); a.w = cvtpk(v[6], v[7]);
    b.x = cvtpk(v[8], v[9]); b.y = cvtpk(v[10], v[11]); b.z = cvtpk(v[12], v[13]); b.w = cvtpk(v[14], v[15]);
    *(u32x4*)dst = a; *(u32x4*)(dst + 8) = b;
}
__device__ __forceinline__ float rstd_from_parts(const float* rssp, int row) {
    const f32x4* p = (const f32x4*)(rssp + (size_t)row * 16); const f32x4 a = p[0], b = p[1], c = p[2], d = p[3];
    const float s = ((a.x + a.y) + (a.z + a.w)) + ((b.x + b.y) + (b.z + b.w)) + ((c.x + c.y) + (c.z + c.w)) + ((d.x + d.y) + (d.z + d.w));
    return rsqrtf(s * (1.0f / DM) + EPS);
}

struct EpiProj {
    const float* rstd0; const float* rope; const float* gq; const float* gks; const float* gkw; const float* gmq; const float* gmk;
    bf16_t *QN, *KC, *VC, *KS, *VS, *KW, *VW, *QM, *KM, *VM, *GA, *GB; float* GN;
    __device__ __forceinline__ void operator()(const Acc& acc, const Unit& u, int wr, int wc, int fr, int fq) const {
        const int slot = u.pn * 4 + wc;
        int kind; bf16_t* base; const float* gain = nullptr; int nh = 1, hh = 0; bool ropeq = false; float sc = 1.f;
        if (slot < 8) { kind = 0; base = QN; gain = gq; nh = 8; hh = slot; ropeq = true; sc = C2; }
        else if (slot < 20) { const int s2 = slot - 8, which = s2 >> 1; kind = 0; nh = 2; hh = s2 & 1;
            base = which == 0 ? KC : which == 1 ? VC : which == 2 ? KS : which == 3 ? VS : which == 4 ? KW : VW;
            if (which == 2) { gain = gks; ropeq = true; } else if (which == 4) { gain = gkw; ropeq = true; } }
        else if (slot < 28) { kind = 0; base = QM; gain = gmq; nh = 8; hh = slot - 20; ropeq = true; sc = C2; }
        else if (slot < 36) { kind = 0; base = KM; gain = gmk; nh = 8; hh = slot - 28; ropeq = true; }
        else if (slot < 44) { kind = 0; base = VM; nh = 8; hh = slot - 36; }
        else if (slot < 60) { kind = 1; base = (bf16_t*)((unsigned char*)GA + (slot - 44) * 64); }
        else if (slot < 76) { kind = 1; base = (bf16_t*)((unsigned char*)GB + (slot - 60) * 64); }
        else if (slot == 76) { kind = 2; base = nullptr; }
        else return;
        float g16[16];
        if (gain) {
#pragma unroll
            for (int c = 0; c < 16; ++c) g16[c] = gain[16 * fq + c] * sc;
        }
        EPI_ROWS_BEGIN
            const float rs = rstd0[row];
            if (kind == 0) {
                if (gain) {
                    float ss = 0.f;
#pragma unroll
                    for (int c = 0; c < 16; ++c) ss += v[c] * v[c];
                    ss += __shfl_xor(ss, 16); ss += __shfl_xor(ss, 32);
                    const float f = rs * rsqrtf(rs * rs * ss * (1.0f / 64.0f) + EPS);
#pragma unroll
                    for (int c = 0; c < 16; ++c) v[c] = v[c] * f * g16[c];
                } else {
#pragma unroll
                    for (int c = 0; c < 16; ++c) v[c] *= rs;
                }
                if (ropeq && fq == 0) {
                    const f32x4* rp = (const f32x4*)(rope + (size_t)row * 16); const f32x4 c0 = rp[0], c1 = rp[1], s0 = rp[2], s1 = rp[3];
                    const float cs[8] = {c0.x, c0.y, c0.z, c0.w, c1.x, c1.y, c1.z, c1.w}, sn[8] = {s0.x, s0.y, s0.z, s0.w, s1.x, s1.y, s1.z, s1.w};
#pragma unroll
                    for (int j = 0; j < 8; ++j) { const float a = v[j], b = v[j + 8]; v[j] = a * cs[j] - b * sn[j]; v[j + 8] = b * cs[j] + a * sn[j]; }
                }
                const int b = row >> 11, t = row & (SEQ - 1);
                store_bf16x16(base + ((size_t)(b * nh + hh) * SEQ + t) * 64 + 16 * fq, v);
            } else if (kind == 1) {
                const float kexp = -1.4426950408889634f * rs;
                unsigned w[4];
#pragma unroll
                for (int c4 = 0; c4 < 4; ++c4) { unsigned pk = 0u;
#pragma unroll
                    for (int i = 0; i < 4; ++i) { const float e = __builtin_amdgcn_exp2f(v[4 * c4 + i] * kexp);
                        pk = __builtin_amdgcn_cvt_pk_u8_f32(__builtin_amdgcn_rcpf(__builtin_fmaf(e, 1.0f / 255.0f, 1.0f / 255.0f)), i, pk); }
                    w[c4] = pk; }
                *(u32x4*)((unsigned char*)base + (size_t)row * DM + 16 * fq) = (u32x4){w[0], w[1], w[2], w[3]};
            } else {
                if (fq < 2) {
#pragma unroll
                    for (int c = 0; c < 16; ++c) v[c] = sigmoidf_(v[c] * rs);
                    f32x4* d = (f32x4*)(GN + (size_t)row * 32 + 16 * fq);
                    d[0] = (f32x4){v[0], v[1], v[2], v[3]}; d[1] = (f32x4){v[4], v[5], v[6], v[7]};
                    if (fq == 0) { d[2] = (f32x4){v[8], v[9], v[10], v[11]}; d[3] = (f32x4){v[12], v[13], v[14], v[15]}; }
                }
            }
        EPI_ROWS_END
    }
};
struct EpiCmp1 {
    const float* b1; bf16_t* hid;
    __device__ __forceinline__ void operator()(const Acc& acc, const Unit& u, int wr, int wc, int fr, int fq) const {
        float bb[16];
#pragma unroll
        for (int c = 0; c < 16; ++c) bb[c] = b1[u.aux * 256 + 64 * wc + 16 * fq + c];
        bf16_t* H = hid + (size_t)u.aux * 4096 * 256;
        EPI_ROWS_BEGIN
#pragma unroll
            for (int c = 0; c < 16; ++c) { const float x = v[c] + bb[c]; v[c] = x * sigmoidf_(x); }
            store_bf16x16(H + (size_t)row * 256 + 64 * wc + 16 * fq, v);
        EPI_ROWS_END
    }
};
struct EpiCmp2 {
    const float* gkc; const float* rope; bf16_t* KCC; bf16_t* VCC;
    __device__ __forceinline__ void operator()(const Acc& acc, const Unit& u, int wr, int wc, int fr, int fq) const {
        if (wc != 0) return;
        float g16[16];
#pragma unroll
        for (int c = 0; c < 16; ++c) g16[c] = gkc[16 * fq + c];
        EPI_ROWS_BEGIN
            const int bg = row >> 7, c_ = row & 127, b = bg >> 1;
            if (u.aux == 0) {
                float ss = 0.f;
#pragma unroll
                for (int c = 0; c < 16; ++c) ss += v[c] * v[c];
                ss += __shfl_xor(ss, 16); ss += __shfl_xor(ss, 32);
                const float rn = rsqrtf(ss * (1.0f / 64.0f) + EPS);
#pragma unroll
                for (int c = 0; c < 16; ++c) v[c] = v[c] * rn * g16[c];
                if (fq == 0) {
                    int tp = c_ * 16 + 31; if (tp > SEQ - 1) tp = SEQ - 1;
                    const f32x4* rp = (const f32x4*)(rope + ((size_t)b * SEQ + tp) * 16); const f32x4 c0 = rp[0], c1 = rp[1], s0 = rp[2], s1 = rp[3];
                    const float cs[8] = {c0.x, c0.y, c0.z, c0.w, c1.x, c1.y, c1.z, c1.w}, sn[8] = {s0.x, s0.y, s0.z, s0.w, s1.x, s1.y, s1.z, s1.w};
#pragma unroll
                    for (int j = 0; j < 8; ++j) { const float a = v[j], bq = v[j + 8]; v[j] = a * cs[j] - bq * sn[j]; v[j + 8] = bq * cs[j] + a * sn[j]; }
                }
                store_bf16x16(KCC + (size_t)row * 64 + 16 * fq, v);
            } else {
                store_bf16x16(VCC + (size_t)row * 64 + 16 * fq, v);
            }
        EPI_ROWS_END
    }
};
struct EpiMerge {
    const bf16_t* GA; const bf16_t* GB; bf16_t* MB;
    __device__ __forceinline__ void operator()(const Acc& acc, const Unit& u, int wr, int wc, int fr, int fq) const {
        const int col = u.pn * 256 + 64 * wc + 16 * fq;
        const unsigned char* G = (const unsigned char*)(u.aux ? GB : GA);
        EPI_ROWS_BEGIN
            const u32x4 g0 = *(const u32x4*)(G + (size_t)row * DM + col);
            const unsigned gw[4] = {g0.x, g0.y, g0.z, g0.w};
#pragma unroll
            for (int c = 0; c < 16; ++c) v[c] *= (float)((gw[c >> 2] >> (8 * (c & 3))) & 255u) * (1.0f / 255.0f);
            bf16_t* mp = MB + (size_t)row * DM + col;
            if (u.aux) {
                const u32x4 m0 = ((const u32x4*)mp)[0], m1 = ((const u32x4*)mp)[1];
                const unsigned mw[8] = {m0.x, m0.y, m0.z, m0.w, m1.x, m1.y, m1.z, m1.w};
#pragma unroll
                for (int c = 0; c < 8; ++c) { v[2 * c] += __builtin_bit_cast(float, mw[c] << 16); v[2 * c + 1] += __builtin_bit_cast(float, mw[c] & 0xffff0000u); }
            }
            store_bf16x16(mp, v);
        EPI_ROWS_END
    }
};
template <bool XF32> struct EpiResid {
    const float* xi; bf16_t* xb; float* rssp;
    __device__ __forceinline__ void operator()(const Acc& acc, const Unit& u, int wr, int wc, int fr, int fq) const {
        const int col = u.pn * 256 + 64 * wc + 16 * fq;
        EPI_ROWS_BEGIN
            bf16_t* bp = xb + (size_t)row * DM + col;
            if (XF32) { const f32x4* ip = (const f32x4*)(xi + (size_t)row * DM + col);
#pragma unroll
                for (int q = 0; q < 4; ++q) { const f32x4 x = ip[q]; v[4 * q] += x.x; v[4 * q + 1] += x.y; v[4 * q + 2] += x.z; v[4 * q + 3] += x.w; } }
            else { const u32x4 m0 = ((const u32x4*)bp)[0], m1 = ((const u32x4*)bp)[1]; const unsigned mw[8] = {m0.x, m0.y, m0.z, m0.w, m1.x, m1.y, m1.z, m1.w};
#pragma unroll
                for (int c = 0; c < 8; ++c) { v[2 * c] += __builtin_bit_cast(float, mw[c] << 16); v[2 * c + 1] += __builtin_bit_cast(float, mw[c] & 0xffff0000u); } }
            float ss = 0.f;
#pragma unroll
            for (int c = 0; c < 16; ++c) ss += v[c] * v[c];
            store_bf16x16(bp, v);
            ss += __shfl_xor(ss, 16); ss += __shfl_xor(ss, 32);
            if (fq == 0) rssp[(size_t)row * 16 + u.pn * 4 + wc] = ss;
        EPI_ROWS_END
    }
};
struct EpiFfnIn {
    const float* rssp; bf16_t* HB;
    __device__ __forceinline__ void operator()(const Acc& acc, const Unit& u, int wr, int wc, int fr, int fq) const {
        const int hcol = u.pn * 128 + 32 * wc + 8 * fq;
        EPI_ROWS_BEGIN
            const float rs = rstd_from_parts(rssp, row);
            float h[8];
            const float kexp = -1.4426950408889634f * rs, irs2 = __builtin_amdgcn_rcpf(rs * rs);
#pragma unroll
            for (int c = 0; c < 8; ++c) { const float e = __builtin_amdgcn_exp2f(v[c] * kexp); h[c] = (v[c] * v[c + 8]) * __builtin_amdgcn_rcpf(__builtin_fmaf(e, irs2, irs2)); }
            u32x4 w; w.x = cvtpk(h[0], h[1]); w.y = cvtpk(h[2], h[3]); w.z = cvtpk(h[4], h[5]); w.w = cvtpk(h[6], h[7]);
            *(u32x4*)(HB + (size_t)row * DFF + hcol) = w;
        EPI_ROWS_END
    }
};
struct EpiStoreBf16 {
    bf16_t* PP;
    __device__ __forceinline__ void operator()(const Acc& acc, const Unit& u, int wr, int wc, int fr, int fq) const {
        const int col = u.pn * 256 + 64 * wc + 16 * fq;
        EPI_ROWS_BEGIN
            store_bf16x16(PP + (size_t)row * DM + col, v);
        EPI_ROWS_END
    }
};
struct EpiPle {
    const float* rssp; const bf16_t* PP; const bf16_t* xb; float* out;
    __device__ __forceinline__ void operator()(const Acc& acc, const Unit& u, int wr, int wc, int fr, int fq) const {
        const int col = u.pn * 256 + 64 * wc + 16 * fq;
        EPI_ROWS_BEGIN
            const float rs = rstd_from_parts(rssp, row); const float kexp = -1.4426950408889634f * rs;
            const u32x4* pp = (const u32x4*)(PP + (size_t)row * DM + col); const u32x4* xp = (const u32x4*)(xb + (size_t)row * DM + col);
            const u32x4 p0 = pp[0], p1 = pp[1], x0 = xp[0], x1 = xp[1];
            const unsigned pw[8] = {p0.x, p0.y, p0.z, p0.w, p1.x, p1.y, p1.z, p1.w}, xw[8] = {x0.x, x0.y, x0.z, x0.w, x1.x, x1.y, x1.z, x1.w};
#pragma unroll
            for (int c = 0; c < 8; ++c) {
                v[2 * c] = __builtin_fmaf(__builtin_amdgcn_rcpf(1.0f + __builtin_amdgcn_exp2f(v[2 * c] * kexp)), __builtin_bit_cast(float, pw[c] << 16), __builtin_bit_cast(float, xw[c] << 16));
                v[2 * c + 1] = __builtin_fmaf(__builtin_amdgcn_rcpf(1.0f + __builtin_amdgcn_exp2f(v[2 * c + 1] * kexp)), __builtin_bit_cast(float, pw[c] & 0xffff0000u), __builtin_bit_cast(float, xw[c] & 0xffff0000u)); }
            f32x4* op = (f32x4*)(out + (size_t)row * DM + col);
#pragma unroll
            for (int q = 0; q < 4; ++q) op[q] = (f32x4){v[4 * q], v[4 * q + 1], v[4 * q + 2], v[4 * q + 3]};
        EPI_ROWS_END
    }
};

struct Args {
    const float* in[26]; const int* pos; float* out; unsigned char* ws;
    float inv_freq[8];
    int ph_lo, ph_hi;
};

__device__ __forceinline__ float wave_sum(float v) {
#pragma unroll
    for (int o = 1; o < 64; o <<= 1) v += __shfl_xor(v, o);
    return v;
}
__device__ __forceinline__ int srccol_win(int L) { if (L < 1280) return L; if (L < 4864) return L + 24; if (L < 4888) return 1280 + (L - 4864); return -1; }
__device__ __forceinline__ int srccol_ffi(int L) { const int tile = L >> 8, l = L & 255, wq = l >> 4, jj = l & 15; const int hid = tile * 128 + wq * 8 + (jj & 7); return (jj < 8 ? 0 : DFF) + hid; }
template <int MAP>
__device__ __forceinline__ void transpose_item(const float* W, int K, int ldw, int nvalid, const float* gain, bf16_t* WT, LAS float* scr, int item, int nblk, int lane) {
    const int kb = item / nblk, nb = item % nblk, k0 = 32 * kb, n0 = 64 * nb;
    const int L = n0 + lane; const int sc = MAP == 1 ? srccol_win(L) : MAP == 2 ? srccol_ffi(L) : (L < nvalid ? L : -1);
    float xv[32];
#pragma unroll
    for (int i = 0; i < 32; ++i) xv[i] = sc >= 0 ? __builtin_nontemporal_load(W + (size_t)(k0 + i) * ldw + sc) : 0.f;
#pragma unroll
    for (int i = 0; i < 32; ++i) { float x = xv[i]; if (gain) x *= gain[k0 + i]; scr[i * 65 + lane] = x; }
    asm volatile("s_waitcnt lgkmcnt(0)" ::: "memory");
    const int ch = lane & 3;
#pragma unroll
    for (int j = 0; j < 4; ++j) { const int nn = (lane >> 2) + 16 * j; const LAS float* s = scr + (8 * ch) * 65 + nn;
        u32x4 o; o.x = cvtpk(s[0], s[65]); o.y = cvtpk(s[2 * 65], s[3 * 65]); o.z = cvtpk(s[4 * 65], s[5 * 65]); o.w = cvtpk(s[6 * 65], s[7 * 65]);
        *(u32x4*)(WT + (size_t)phys_col(n0 + nn) * K + k0 + 8 * ch) = o; }
    asm volatile("s_waitcnt lgkmcnt(0)" ::: "memory");
}

__device__ __forceinline__ void p0_prologue(const Args& a, LAS unsigned char* lds, int tid, int lane, int wave) {
    unsigned char* ws = a.ws;
    LAS float* scr = (LAS float*)(lds + wave * 16384);
    const int gw = (int)blockIdx.x * 8 + wave, NGW = (int)gridDim.x * 8;
    constexpr int I_WIN = 32 * 80, I_UP = 16 * 16, I_OUT = 32 * 16, I_FFI = 32 * 88, I_FFO = 88 * 16, I_PG = 32 * 16, I_PP = 8 * 16, I_C1 = 64 * 4, I_C2 = 8 * 4;
    constexpr int NIT = I_WIN + 2 * I_UP + I_OUT + I_FFI + I_FFO + I_PG + I_PP + 2 * I_C1 + 2 * I_C2;
    for (int it0 = gw; it0 < NIT * NREP(0); it0 += NGW) {
        int r = it0 % NIT;
        if (r < I_WIN) { transpose_item<1>(a.in[4], 1024, IN_COLS, 0, a.in[3], (bf16_t*)(ws + WS_WIN), scr, r, 80, lane); continue; } r -= I_WIN;
        if (r < I_FFI) { transpose_item<2>(a.in[21], 1024, 2 * DFF, 0, a.in[20], (bf16_t*)(ws + WS_WFFI), scr, r, 88, lane); continue; } r -= I_FFI;
        if (r < I_FFO) { transpose_item<0>(a.in[22], DFF, 1024, 1024, nullptr, (bf16_t*)(ws + WS_WFFO), scr, r, 16, lane); continue; } r -= I_FFO;
        if (r < I_OUT) { transpose_item<0>(a.in[19], 1024, 1024, 1024, nullptr, (bf16_t*)(ws + WS_WOUT), scr, r, 16, lane); continue; } r -= I_OUT;
        if (r < I_PG) { transpose_item<0>(a.in[24], 1024, 1024, 1024, a.in[23], (bf16_t*)(ws + WS_WPG), scr, r, 16, lane); continue; } r -= I_PG;
        if (r < I_UP) { transpose_item<0>(a.in[17], 512, 1024, 1024, nullptr, (bf16_t*)(ws + WS_WUPN), scr, r, 16, lane); continue; } r -= I_UP;
        if (r < I_UP) { transpose_item<0>(a.in[18], 512, 1024, 1024, nullptr, (bf16_t*)(ws + WS_WUPM), scr, r, 16, lane); continue; } r -= I_UP;
        if (r < I_PP) { transpose_item<0>(a.in[25], 256, 1024, 1024, nullptr, (bf16_t*)(ws + WS_WPP), scr, r, 16, lane); continue; } r -= I_PP;
        if (r < I_C1) { transpose_item<0>(a.in[11], 2048, 256, 256, nullptr, (bf16_t*)(ws + WS_WCK1), scr, r, 4, lane); continue; } r -= I_C1;
        if (r < I_C1) { transpose_item<0>(a.in[13], 2048, 256, 256, nullptr, (bf16_t*)(ws + WS_WCV1), scr, r, 4, lane); continue; } r -= I_C1;
        if (r < I_C2) { transpose_item<0>(a.in[12], 256, 64, 64, nullptr, (bf16_t*)(ws + WS_WCK2), scr, r, 4, lane); continue; } r -= I_C2;
        transpose_item<0>(a.in[14], 256, 64, 64, nullptr, (bf16_t*)(ws + WS_WCV2), scr, r, 4, lane);
    }
    {
        const float* x = a.in[0]; bf16_t* XB = (bf16_t*)(ws + WS_XB); float* rstd0 = (float*)(ws + WS_RSTD0);
        const float* p = a.in[1]; bf16_t* PB = (bf16_t*)(ws + WS_PB);
        for (int m0 = gw; m0 < T * NREP(0); m0 += NGW) { const int m = m0 % T;
            const f32x4* xr = (const f32x4*)(x + (size_t)m * DM) + lane; f32x4 v[4]; float s = 0.f;
#pragma unroll
            for (int j = 0; j < 4; ++j) { v[j] = __builtin_nontemporal_load(xr + 64 * j); s += (v[j].x * v[j].x + v[j].y * v[j].y) + (v[j].z * v[j].z + v[j].w * v[j].w); }
            const f32x4 pv = __builtin_nontemporal_load((const f32x4*)(p + (size_t)m * PLE) + lane);
            s = wave_sum(s);
            if (lane == 0) rstd0[m] = rsqrtf(s * (1.0f / DM) + EPS);
            u32x2* o8 = (u32x2*)(XB + (size_t)m * DM) + lane;
#pragma unroll
            for (int j = 0; j < 4; ++j) o8[64 * j] = (u32x2){cvtpk(v[j].x, v[j].y), cvtpk(v[j].z, v[j].w)};
            ((u32x2*)(PB + (size_t)m * PLE))[lane] = (u32x2){cvtpk(pv.x, pv.y), cvtpk(pv.z, pv.w)};
        }
    }
    {
        float* rope = (float*)(ws + WS_ROPE); const int gt = (int)blockIdx.x * 512 + tid, NGT = (int)gridDim.x * 512;
        const float f0 = a.inv_freq[0], f1 = a.inv_freq[1], f2 = a.inv_freq[2], f3 = a.inv_freq[3], f4 = a.inv_freq[4], f5 = a.inv_freq[5], f6 = a.inv_freq[6], f7 = a.inv_freq[7];
        for (int row0 = gt; row0 < T * NREP(0); row0 += NGT) { const int row = row0 % T; const float pf = (float)a.pos[row]; const float fr8[8] = {f0, f1, f2, f3, f4, f5, f6, f7}; float cs[8], sn[8];
#pragma unroll
            for (int j = 0; j < 8; ++j) { const float ang = pf * fr8[j]; double rev = (double)ang * 0.15915494309189535; rev -= floor(rev); const float fr = (float)rev;
                cs[j] = __builtin_amdgcn_cosf(fr); sn[j] = __builtin_amdgcn_sinf(fr); }
            f32x4* o = (f32x4*)(rope + (size_t)row * 16);
            o[0] = (f32x4){cs[0], cs[1], cs[2], cs[3]}; o[1] = (f32x4){cs[4], cs[5], cs[6], cs[7]}; o[2] = (f32x4){sn[0], sn[1], sn[2], sn[3]}; o[3] = (f32x4){sn[4], sn[5], sn[6], sn[7]}; }
    }
    {
        float* pb = (float*)(ws + WS_PBIAS);
        if (wave == 0) for (int it = (int)blockIdx.x; it < 256; it += (int)gridDim.x) { const int kv = it >> 7, kc = it & 127; const float* pe = kv ? a.in[10] : a.in[9]; const float* w1 = kv ? a.in[13] : a.in[11];
            float s0 = 0.f, s1 = 0.f, s2 = 0.f, s3 = 0.f;
#pragma unroll
            for (int kk = 0; kk < 16; ++kk) { const int k = kc * 16 + kk; const float pv = pe[k]; const float* wr = w1 + (size_t)k * 256 + lane;
                s0 += pv * wr[0]; s1 += pv * wr[64]; s2 += pv * wr[128]; s3 += pv * wr[192]; }
            float* o = pb + (size_t)(kv * 128 + kc) * 256 + lane; o[0] = s0; o[64] = s1; o[128] = s2; o[192] = s3; }
    }
}

__device__ __forceinline__ void kmean_phase(const Args& a, int lane, int wave) {
    const bf16_t* KM = (const bf16_t*)(a.ws + WS_KM); float* KMEAN = (float*)(a.ws + WS_KMEAN);
    const int gw = (int)blockIdx.x * 8 + wave, NGW = (int)gridDim.x * 8;
    for (int it0 = gw; it0 < NB * MOBA_H * 8 * NREP(2); it0 += NGW) { const int it = it0 % (NB * MOBA_H * 8);
        const u32x4* src = (const u32x4*)(KM + (size_t)it * 256 * 64) + lane; float s[8];
#pragma unroll
        for (int c = 0; c < 8; ++c) s[c] = 0.f;
        u32x4 wv[32];
#pragma unroll
        for (int i = 0; i < 32; ++i) wv[i] = src[64 * i];
#pragma unroll
        for (int i = 0; i < 32; ++i) { const u32x4 w = wv[i]; const unsigned ww[4] = {w.x, w.y, w.z, w.w};
#pragma unroll
            for (int c = 0; c < 4; ++c) { s[2 * c] += __builtin_bit_cast(float, ww[c] << 16); s[2 * c + 1] += __builtin_bit_cast(float, ww[c] & 0xffff0000u); } }
#pragma unroll
        for (int c = 0; c < 8; ++c) { s[c] += __shfl_xor(s[c], 8); s[c] += __shfl_xor(s[c], 16); s[c] += __shfl_xor(s[c], 32); }
        if (lane < 8) { f32x4* o = (f32x4*)(KMEAN + (size_t)it * 64 + lane * 8);
            o[0] = (f32x4){s[0], s[1], s[2], s[3]} * (1.0f / 256.0f); o[1] = (f32x4){s[4], s[5], s[6], s[7]} * (1.0f / 256.0f); }
    }
}

constexpr int KROW = 144, VROW = 192;
constexpr int L_K = 0, L_V = 2 * 64 * KROW, L_IMP = L_V + 2 * 64 * VROW, L_SEL = L_IMP + 4 * 64 * 33 * 4, L_KMEAN = L_SEL + 256, L_Q = L_KMEAN + 2048, L_Y = L_Q + 64, L_ATT_END = L_Y + 65536;
static_assert(L_ATT_END <= 147456, "attention LDS");
struct AttnState { float m, l; f32x16 o[2]; f32x16 negm; };
__device__ __forceinline__ void attn_reset(AttnState& st) { st.m = 0.f; st.l = 0.f;
#pragma unroll
    for (int r = 0; r < 16; ++r) { st.o[0][r] = 0.f; st.o[1][r] = 0.f; st.negm[r] = 0.f; } }
__device__ __forceinline__ s16x4 vtr(const LAS unsigned char* p) { return __builtin_bit_cast(s16x4, __builtin_amdgcn_ds_read_tr16_b64_v4i16((LAS s16x4*)p)); }
__device__ __forceinline__ void pv_subtile(AttnState& st, const LAS unsigned char* vb, const f32x16& p) {
    u32x4 w0, w1; w0.x = cvtpk(p[0], p[1]); w0.y = cvtpk(p[2], p[3]); w0.z = cvtpk(p[4], p[5]); w0.w = cvtpk(p[6], p[7]);
    w1.x = cvtpk(p[8], p[9]); w1.y = cvtpk(p[10], p[11]); w1.z = cvtpk(p[12], p[13]); w1.w = cvtpk(p[14], p[15]);
    const bf16x8 pf0 = __builtin_bit_cast(bf16x8, w0), pf1 = __builtin_bit_cast(bf16x8, w1);
#pragma unroll
    for (int dh = 0; dh < 2; ++dh) {
        const s16x4 a0 = vtr(vb + dh * 64), a1 = vtr(vb + dh * 64 + 8 * VROW), b0 = vtr(vb + dh * 64 + 16 * VROW), b1 = vtr(vb + dh * 64 + 24 * VROW);
        const bf16x8 vf0 = {a0[0], a0[1], a0[2], a0[3], a1[0], a1[1], a1[2], a1[3]}, vf1 = {b0[0], b0[1], b0[2], b0[3], b1[0], b1[1], b1[2], b1[3]};
        st.o[dh] = __builtin_amdgcn_mfma_f32_32x32x16_bf16(vf0, pf0, st.o[dh], 0, 0, 0);
        st.o[dh] = __builtin_amdgcn_mfma_f32_32x32x16_bf16(vf1, pf1, st.o[dh], 0, 0, 0);
    }
}
struct VFrags { s16x4 f[2][4]; };
__device__ __forceinline__ VFrags v_preload(const LAS unsigned char* vb) { VFrags v;
#pragma unroll
    for (int dh = 0; dh < 2; ++dh) { v.f[dh][0] = vtr(vb + dh * 64); v.f[dh][1] = vtr(vb + dh * 64 + 8 * VROW); v.f[dh][2] = vtr(vb + dh * 64 + 16 * VROW); v.f[dh][3] = vtr(vb + dh * 64 + 24 * VROW); }
    return v; }
__device__ __forceinline__ void pv_subtile_pre(AttnState& st, const VFrags& v, const f32x16& p) {
    u32x4 w0, w1; w0.x = cvtpk(p[0], p[1]); w0.y = cvtpk(p[2], p[3]); w0.z = cvtpk(p[4], p[5]); w0.w = cvtpk(p[6], p[7]);
    w1.x = cvtpk(p[8], p[9]); w1.y = cvtpk(p[10], p[11]); w1.z = cvtpk(p[12], p[13]); w1.w = cvtpk(p[14], p[15]);
    const bf16x8 pf0 = __builtin_bit_cast(bf16x8, w0), pf1 = __builtin_bit_cast(bf16x8, w1);
#pragma unroll
    for (int dh = 0; dh < 2; ++dh) {
        const s16x4 a0 = v.f[dh][0], a1 = v.f[dh][1], b0 = v.f[dh][2], b1 = v.f[dh][3];
        const bf16x8 vf0 = {a0[0], a0[1], a0[2], a0[3], a1[0], a1[1], a1[2], a1[3]}, vf1 = {b0[0], b0[1], b0[2], b0[3], b1[0], b1[1], b1[2], b1[3]};
        st.o[dh] = __builtin_amdgcn_mfma_f32_32x32x16_bf16(vf0, pf0, st.o[dh], 0, 0, 0);
        st.o[dh] = __builtin_amdgcn_mfma_f32_32x32x16_bf16(vf1, pf1, st.o[dh], 0, 0, 0);
    }
}
__device__ __forceinline__ void attn_tile(const LAS unsigned char* kb, const LAS unsigned char* vb, const bf16x8 (&q)[4], AttnState& st, bool rowok, int lo, int hi, int lane) {
    const int r32 = lane & 31, h = lane >> 5;
    const bool live = rowok && lo <= hi && hi >= 0 && lo <= 63;
    if (!__any(live)) return;
    const bool full = rowok && lo <= 0 && hi >= 63;
    const bool rowmask_only = __all(full || !live);
    const float cm = (rowmask_only && !full) ? -INFINITY : 0.f;
    f32x16 cinit;
#pragma unroll
    for (int r = 0; r < 16; ++r) cinit[r] = st.negm[r] + cm;
    const LAS unsigned char* kp = kb + r32 * KROW + h * 16;
    f32x16 s0, s1;
    { const bf16x8 k0 = *(const LAS bf16x8*)(kp), k1 = *(const LAS bf16x8*)(kp + 32 * KROW);
      s0 = __builtin_amdgcn_mfma_f32_32x32x16_bf16(k0, q[0], cinit, 0, 0, 0);
      s1 = __builtin_amdgcn_mfma_f32_32x32x16_bf16(k1, q[0], cinit, 0, 0, 0); }
#pragma unroll
    for (int ks = 1; ks < 4; ++ks) {
        const bf16x8 k0 = *(const LAS bf16x8*)(kp + ks * 32), k1 = *(const LAS bf16x8*)(kp + 32 * KROW + ks * 32);
        s0 = __builtin_amdgcn_mfma_f32_32x32x16_bf16(k0, q[ks], s0, 0, 0, 0);
        s1 = __builtin_amdgcn_mfma_f32_32x32x16_bf16(k1, q[ks], s1, 0, 0, 0);
    }
    const LAS unsigned char* vp = vb + (4 * h + ((lane & 15) >> 2)) * VROW + (16 * ((lane >> 4) & 1) + 4 * (lane & 3)) * 2;
    const VFrags vf0 = v_preload(vp);
    __builtin_amdgcn_sched_barrier(0);
    if (!rowmask_only) {
#pragma unroll
        for (int r = 0; r < 16; ++r) { const int kk = (r & 3) + 8 * (r >> 2) + 4 * h;
            if (!(live && kk >= lo && kk <= hi)) s0[r] = -INFINITY;
            if (!(live && kk + 32 >= lo && kk + 32 <= hi)) s1[r] = -INFINITY; }
    }
    float mx = fmaxf(fmaxf(s0[0], s1[0]), fmaxf(s0[1], s1[1]));
#pragma unroll
    for (int r = 2; r < 16; r += 2) mx = fmaxf(fmaxf(mx, s0[r]), fmaxf(s1[r], fmaxf(s0[r + 1], s1[r + 1])));
    mx = fmaxf(mx, swap32(mx));
    if (__any(mx > 8.0f)) {
        const float d = fmaxf(mx, 0.f), alpha = __builtin_amdgcn_exp2f(-d);
        st.m += d; st.l *= alpha;
#pragma unroll
        for (int r = 0; r < 16; ++r) { s0[r] -= d; s1[r] -= d; st.o[0][r] *= alpha; st.o[1][r] *= alpha; st.negm[r] = -st.m; }
    }
    float ls0 = 0.f, ls1 = 0.f;
#pragma unroll
    for (int r = 0; r < 16; ++r) { s0[r] = __builtin_amdgcn_exp2f(s0[r]); s1[r] = __builtin_amdgcn_exp2f(s1[r]); ls0 += s0[r]; ls1 += s1[r]; }
    st.l += ls0 + ls1;
    const VFrags vf1 = v_preload(vp + 32 * VROW);
    pv_subtile_pre(st, vf0, s0);
    pv_subtile_pre(st, vf1, s1);
}
template <bool FIRST>
__device__ __forceinline__ void attn_fold(LAS float* yl, const AttnState& st, float gate) {
    const float lt = st.l + swap32(st.l); const float f = lt > 0.f ? gate / lt : 0.f;
#pragma unroll
    for (int dh = 0; dh < 2; ++dh)
#pragma unroll
        for (int r = 0; r < 16; ++r) { float v = f * st.o[dh][r]; if (!FIRST) v += yl[(dh * 16 + r) * 512]; yl[(dh * 16 + r) * 512] = v; }
}
struct KVRegs { u32x4 k, v; };
__device__ __forceinline__ KVRegs kv_load(const unsigned char* Kg, const unsigned char* Vg, int tile, int tid) {
    KVRegs r; r.k = *(const u32x4*)(Kg + (size_t)tile * 8192 + tid * 16); r.v = *(const u32x4*)(Vg + (size_t)tile * 8192 + tid * 16); return r; }
__device__ __forceinline__ void kv_store(LAS unsigned char* lds, const KVRegs& r, int buf, int tid) {
    *(LAS u32x4*)(lds + L_K + buf * 64 * KROW + (tid >> 3) * KROW + (tid & 7) * 16) = r.k;
    *(LAS u32x4*)(lds + L_V + buf * 64 * VROW + (tid >> 3) * VROW + (tid & 7) * 16) = r.v; }
#define LDS_BAR() asm volatile("s_waitcnt lgkmcnt(0)\n\ts_barrier" ::: "memory")
template <class MF>
__device__ __forceinline__ void attn_pass(LAS unsigned char* lds, const unsigned char* Kg, const unsigned char* Vg, int t_lo, int t_hi, const bf16x8 (&q)[4], AttnState& st, const MF& mf, int tid, int lane) {
    const int n = t_hi - t_lo + 1;
    KVRegs rA = kv_load(Kg, Vg, t_lo, tid), rB = rA;
    if (n > 1) rB = kv_load(Kg, Vg, t_lo + 1, tid);
    for (int i = 0; i < n; i += 2) {
        kv_store(lds, rA, 0, tid);
        LDS_BAR();
        if (i + 2 < n) rA = kv_load(Kg, Vg, t_lo + i + 2, tid);
        { bool rowok; int lo, hi; mf(t_lo + i, rowok, lo, hi);
          attn_tile(lds + L_K, lds + L_V, q, st, rowok, lo, hi, lane); }
        if (i + 1 < n) {
            kv_store(lds, rB, 1, tid);
            LDS_BAR();
            if (i + 3 < n) rB = kv_load(Kg, Vg, t_lo + i + 3, tid);
            bool rowok; int lo, hi; mf(t_lo + i + 1, rowok, lo, hi);
            attn_tile(lds + L_K + 64 * KROW, lds + L_V + 64 * VROW, q, st, rowok, lo, hi, lane);
        }
    }
    __syncthreads();
}
__device__ __forceinline__ void store_y(bf16_t* dst, const f32x16 (&y)[2], int h) {
#pragma unroll
    for (int dh = 0; dh < 2; ++dh)
#pragma unroll
        for (int g4 = 0; g4 < 4; ++g4) *(u32x2*)(dst + 32 * dh + 8 * g4 + 4 * h) = (u32x2){cvtpk(y[dh][4 * g4], y[dh][4 * g4 + 1]), cvtpk(y[dh][4 * g4 + 2], y[dh][4 * g4 + 3])};
}

__device__ __forceinline__ void nsa_unit(const Args& a, LAS unsigned char* lds, int b, int g, int qc, int tid, int lane, int wave) {
    unsigned char* ws = a.ws;
    const int r32 = lane & 31, h = lane >> 5, hl = wave >> 1, head = g * 4 + hl, tt = 32 * (wave & 1) + r32, t = 64 * qc + tt;
    const size_t row = (size_t)b * SEQ + t; const int bg = b * 2 + g;
    bf16x8 q[4];
    { const bf16_t* qp = (const bf16_t*)(ws + WS_QN) + ((size_t)(b * 8 + head) * SEQ + t) * 64 + 8 * h;
#pragma unroll
      for (int ks = 0; ks < 4; ++ks) q[ks] = *(const bf16x8*)(qp + 16 * ks); }
    const float* gn = (const float*)(ws + WS_GN) + row * 32 + head * 3; const float g_c = gn[0], g_s = gn[1], g_w = gn[2];
    LAS float* yl = (LAS float*)(lds + L_Y) + tid;
    {
        const unsigned char* Kg = ws + WS_KCC + (size_t)bg * 128 * 128; const unsigned char* Vg = ws + WS_VCC + (size_t)bg * 128 * 128;
#pragma unroll
        for (int i = 0; i < 2; ++i) { const int idx = tid + 512 * i; const u32x4 kk = *(const u32x4*)(Kg + idx * 16), vv = *(const u32x4*)(Vg + idx * 16);
            *(LAS u32x4*)(lds + L_K + (idx >> 3) * KROW + (idx & 7) * 16) = kk; *(LAS u32x4*)(lds + L_V + (idx >> 3) * VROW + (idx & 7) * 16) = vv; }
        __syncthreads();
        const int cmax = t >= 31 ? ((t - 31) >> 4) : -1;
        f32x16 s[4];
        const LAS unsigned char* kp = lds + L_K + r32 * KROW + h * 16;
#pragma unroll
        for (int p = 0; p < 4; ++p) {
#pragma unroll
            for (int r = 0; r < 16; ++r) s[p][r] = 0.f;
#pragma unroll
            for (int ks = 0; ks < 4; ++ks) s[p] = __builtin_amdgcn_mfma_f32_32x32x16_bf16(*(const LAS bf16x8*)(kp + p * 32 * KROW + ks * 32), q[ks], s[p], 0, 0, 0);
        }
        float mx = -INFINITY;
#pragma unroll
        for (int p = 0; p < 4; ++p)
#pragma unroll
            for (int r = 0; r < 16; ++r) { const int c = 32 * p + (r & 3) + 8 * (r >> 2) + 4 * h; if (c > cmax) s[p][r] = -INFINITY; mx = fmaxf(mx, s[p][r]); }
        mx = fmaxf(mx, swap32(mx));
        const float msafe = (mx == -INFINITY) ? 0.f : mx; float ls = 0.f;
#pragma unroll
        for (int p = 0; p < 4; ++p)
#pragma unroll
            for (int r = 0; r < 16; ++r) { s[p][r] = __builtin_amdgcn_exp2f(s[p][r] - msafe); ls += s[p][r]; }
        ls += swap32(ls);
        const float inv = 1.0f / fmaxf(ls, 1e-30f);
#pragma unroll
        for (int p = 0; p < 4; ++p)
#pragma unroll
            for (int r = 0; r < 16; ++r) s[p][r] *= inv;
        LAS float* imp = (LAS float*)(lds + L_IMP) + (hl * 64 + tt) * 33;
        AttnState st; attn_reset(st);
        const LAS unsigned char* vp = lds + L_V + (4 * h + ((lane & 15) >> 2)) * VROW + (16 * ((lane >> 4) & 1) + 4 * (lane & 3)) * 2;
        float eprev = 0.f;
#pragma unroll
        for (int p = 0; p < 4; ++p) {
#pragma unroll
            for (int g4 = 0; g4 < 4; ++g4) {
                const float Gv = (s[p][4 * g4] + s[p][4 * g4 + 1]) + (s[p][4 * g4 + 2] + s[p][4 * g4 + 3]);
                const float esw = swap32(s[p][4 * g4 + 3]);
                imp[8 * p + 2 * g4 + h] = Gv + (h ? esw : eprev);
                eprev = esw;
            }
            pv_subtile(st, vp + p * 32 * VROW, s[p]);
        }
#pragma unroll
        for (int dh = 0; dh < 2; ++dh)
#pragma unroll
            for (int r = 0; r < 16; ++r) yl[(dh * 16 + r) * 512] = g_c * st.o[dh][r];
        __syncthreads();
        {
            const int tok = tid >> 3, sub = tid & 7, cur = qc; unsigned msk;
            if (cur - 2 <= 5) msk = (cur >= 31) ? 0xffffffffu : ((1u << (cur + 1)) - 1u);
            else {
                const LAS float* ip = (const LAS float*)(lds + L_IMP) + tok * 33 + sub * 4;
                float v4[4];
#pragma unroll
                for (int jj = 0; jj < 4; ++jj) { const int j = sub * 4 + jj; const float vj = ((ip[jj] + ip[64 * 33 + jj]) + ip[2 * 64 * 33 + jj]) + ip[3 * 64 * 33 + jj]; v4[jj] = (j >= 1 && j <= cur - 2) ? vj : -1.f; }
                msk = 1u | (1u << cur) | (1u << (cur - 1));
#pragma unroll
                for (int pick = 0; pick < 5; ++pick) {
                    float bv = v4[0]; int bj = sub * 4;
#pragma unroll
                    for (int jj = 1; jj < 4; ++jj) if (v4[jj] > bv) { bv = v4[jj]; bj = sub * 4 + jj; }
#pragma unroll
                    for (int off = 1; off < 8; off <<= 1) { const float ov = __shfl_xor(bv, off); const int oj = __shfl_xor(bj, off); if (ov > bv || (ov == bv && oj < bj)) { bv = ov; bj = oj; } }
                    msk |= 1u << bj;
#pragma unroll
                    for (int jj = 0; jj < 4; ++jj) if (sub * 4 + jj == bj) v4[jj] = -1.f;
                }
            }
            if (sub == 0) ((LAS unsigned*)(lds + L_SEL))[tok] = msk;
        }
        __syncthreads();
    }
    const unsigned selm = ((const LAS unsigned*)(lds + L_SEL))[tt];
    {
        AttnState st; attn_reset(st);
        auto mf = [&](int j, bool& rowok, int& lo, int& hi) { rowok = (selm >> j) & 1u; lo = 0; hi = (j == qc) ? tt : 63; };
        attn_pass(lds, ws + WS_KS + (size_t)bg * SEQ * 128, ws + WS_VS + (size_t)bg * SEQ * 128, 0, qc, q, st, mf, tid, lane);
        attn_fold<false>(yl, st, g_s);
    }
    {
        AttnState st; attn_reset(st);
        const int jl = qc - 8;
        auto mf = [&](int j, bool& rowok, int& lo, int& hi) { rowok = true; lo = (j == jl) ? tt + 1 : 0; hi = (j == qc) ? tt : 63; };
        attn_pass(lds, ws + WS_KW + (size_t)bg * SEQ * 128, ws + WS_VW + (size_t)bg * SEQ * 128, jl < 0 ? 0 : jl, qc, q, st, mf, tid, lane);
        attn_fold<false>(yl, st, g_w);
    }
    f32x16 y[2];
#pragma unroll
    for (int dh = 0; dh < 2; ++dh)
#pragma unroll
        for (int r = 0; r < 16; ++r) y[dh][r] = yl[(dh * 16 + r) * 512];
    store_y((bf16_t*)(ws + WS_YN) + row * 512 + head * 64, y, h);
}

__device__ __forceinline__ void moba_unit(const Args& a, LAS unsigned char* lds, int b, int hd, int own, int tid, int lane, int wave) {
    unsigned char* ws = a.ws;
    const int r32 = lane & 31, h = lane >> 5, tb = 32 * wave + r32, t = 256 * own + tb;
    const size_t row = (size_t)b * SEQ + t; const int bh = b * 8 + hd;
    bf16x8 q[4];
    { const bf16_t* qp = (const bf16_t*)(ws + WS_QM) + ((size_t)bh * SEQ + t) * 64 + 8 * h;
#pragma unroll
      for (int ks = 0; ks < 4; ++ks) q[ks] = *(const bf16x8*)(qp + 16 * ks); }
    unsigned msk;
    if (own <= 3) msk = (1u << own) - 1u;
    else {
        { const float* km = (const float*)(ws + WS_KMEAN) + (size_t)bh * 8 * 64; ((LAS float*)(lds + L_KMEAN))[tid] = km[tid]; }
        __syncthreads();
        float sc[7];
#pragma unroll
        for (int n = 0; n < 7; ++n) { float d = 0.f;
            if (n < own) {
                const LAS float* kmn = (const LAS float*)(lds + L_KMEAN) + n * 64 + 8 * h;
#pragma unroll
                for (int ks = 0; ks < 4; ++ks)
#pragma unroll
                    for (int j = 0; j < 8; ++j) d += bf2f((unsigned short)q[ks][j]) * kmn[16 * ks + j];
                d += swap32(d);
            }
            sc[n] = d; }
        msk = 0u;
        for (int pick = 0; pick < 3; ++pick) { int best = 0; float bv = -INFINITY;
#pragma unroll
            for (int n = 0; n < 7; ++n) if (n < own && !((msk >> n) & 1u) && sc[n] > bv) { bv = sc[n]; best = n; }
            msk |= 1u << best; }
        __syncthreads();
    }
    AttnState st; attn_reset(st);
    auto mf = [&](int kt, bool& rowok, int& lo, int& hi) { const int n = kt >> 2; lo = 0;
        if (n < own) { rowok = (msk >> n) & 1u; hi = 63; } else { rowok = true; const int d = tb - 64 * (kt & 3); hi = d > 63 ? 63 : d; } };
    attn_pass(lds, ws + WS_KM + (size_t)bh * SEQ * 128, ws + WS_VM + (size_t)bh * SEQ * 128, 0, 4 * own + 3, q, st, mf, tid, lane);
    { const float lt = st.l + swap32(st.l); const float f = lt > 0.f ? 1.0f / lt : 0.f;
#pragma unroll
      for (int r = 0; r < 16; ++r) { st.o[0][r] *= f; st.o[1][r] *= f; } }
    store_y((bf16_t*)(ws + WS_YM) + row * 512 + hd * 64, st.o, h);
}

__device__ __forceinline__ bool decode_unit(int u, int& type, int& par, int& sub) {
    if (u < 1024) { type = 1; par = 7 - (u >> 7); sub = u & 127; return true; }
    u -= 1024;
    if (u < 1024) { type = 0; par = 31 - (u >> 5); sub = u & 31; return true; }
    return false;
}
__device__ __forceinline__ void attention_phase(const Args& a, LAS unsigned char* lds, int tid, int lane, int wave, int rep) {
    unsigned* ctr = (unsigned*)(a.ws + WS_CTL) + rep;
    unsigned* cflag = (unsigned*)(a.ws + WS_CTL) + 16 + rep;
    if (blockIdx.x < 32) {
        unsigned char* ws = a.ws;
        { SchedCmp S{(const char*)(ws + WS_KC), (const char*)(ws + WS_VC), (const char*)(ws + WS_WCK1), (const char*)(ws + WS_WCV1), (size_t)256 * 1024 * 2};
          EpiCmp1 E{(const float*)(ws + WS_B1), (bf16_t*)(ws + WS_HID)};
          pg8::gemm_phase(lds, 2048, 1024, 2048, S, E); }
        asm volatile("s_waitcnt vmcnt(0)" ::: "memory"); __builtin_amdgcn_fence(__ATOMIC_RELEASE, "agent"); __syncthreads(); __builtin_amdgcn_fence(__ATOMIC_ACQUIRE, "agent");
        { SchedCmp S{(const char*)(ws + WS_HID), (const char*)(ws + WS_HID) + (size_t)4096 * 256 * 2, (const char*)(ws + WS_WCK2), (const char*)(ws + WS_WCV2), (size_t)256 * 256 * 2};
          EpiCmp2 E{a.in[6], (const float*)(ws + WS_ROPE), (bf16_t*)(ws + WS_KCC), (bf16_t*)(ws + WS_VCC)};
          pg8::gemm_phase(lds, 256, 256, 256, S, E); }
        asm volatile("s_waitcnt vmcnt(0)" ::: "memory"); __builtin_amdgcn_fence(__ATOMIC_RELEASE, "agent"); __syncthreads();
        if (tid == 0) __hip_atomic_fetch_add(cflag, 1u, __ATOMIC_RELEASE, __HIP_MEMORY_SCOPE_AGENT);
    }
    bool cmp_ready = false;
    unsigned unext = 0u;
    if (tid == 0) unext = atomicAdd(ctr, 1u);
    for (;;) {
        if (tid == 0) ((LAS unsigned*)(lds + L_Q))[0] = unext;
        __syncthreads();
        const int u = (int)((LAS unsigned*)(lds + L_Q))[0];
        __syncthreads();
        int type, par, sub;
        if (!decode_unit(u, type, par, sub)) break;
        if (tid == 0) unext = atomicAdd(ctr, 1u);
        if (type == 0 && !cmp_ready) {
            if (tid == 0) { unsigned sp = 0; while (__hip_atomic_load(cflag, __ATOMIC_RELAXED, __HIP_MEMORY_SCOPE_AGENT) < 32u) { __builtin_amdgcn_s_sleep(8); if (++sp > (1u << 22)) break; } }
            __syncthreads(); __builtin_amdgcn_fence(__ATOMIC_ACQUIRE, "agent"); cmp_ready = true;
        }
        if (type == 0) nsa_unit(a, lds, sub >> 1, sub & 1, par, tid, lane, wave);
        else moba_unit(a, lds, sub >> 3, sub & 7, par, tid, lane, wave);
    }
}

#define XB_TMO      128
#define XB_XCNT(j)  (256  + 64 * (j))
#define XB_XSUB(j)  (1280 + 64 * (j))
#define XB_XGEN(j)  (2304 + 64 * (j))
#define XB_TOP      3328
#define XB_TOPGEN   3392
#define XCD_BAR_WORDS 3456
#define XB_SPIN_CAP (1u << 18)
__device__ __forceinline__ unsigned xb_ld(unsigned* p)              { return __hip_atomic_load(p, __ATOMIC_RELAXED, __HIP_MEMORY_SCOPE_AGENT); }
__device__ __forceinline__ unsigned xb_add(unsigned* p, unsigned v) { return __hip_atomic_fetch_add(p, v, __ATOMIC_RELAXED, __HIP_MEMORY_SCOPE_AGENT); }
__device__ __forceinline__ unsigned xb_xcc_id() { return (unsigned)__builtin_amdgcn_s_getreg((3 << 11) | 20) & 0xFu; }
#define XB_SPIN(cond, bar) do { unsigned _sp = 0; while (cond) { __builtin_amdgcn_s_sleep(1); \
    if ((++_sp & 255u) == 0u) { if (xb_ld(&(bar)[XB_TMO])) break; if (_sp > XB_SPIN_CAP) { atomicAdd(&(bar)[XB_TMO], 1u); break; } } } } while (0)
struct XcdBarrier { unsigned* bar; unsigned x; volatile LAS unsigned* st; };
__device__ __forceinline__ XcdBarrier xcd_barrier_post(unsigned* bar, volatile LAS unsigned* st) {
    XcdBarrier b; b.bar = bar; b.x = xb_xcc_id(); b.st = st;
    if (threadIdx.x == 0) (void)xb_add(&bar[XB_XCNT(b.x)], 1u);
    return b;
}
__device__ __forceinline__ void xcd_barrier_complete(unsigned* bar, unsigned x, unsigned& nloc, unsigned& nx) {
    const unsigned G = gridDim.x * gridDim.y * gridDim.z;
    unsigned sum, cnt, mine, sp = 0u;
    for (;;) {
        sum = 0u; cnt = 0u; mine = 0u;
#pragma unroll
        for (unsigned j = 0; j < 16; ++j) { const unsigned c = xb_ld(&bar[XB_XCNT(j)]); sum += c; cnt += (c > 0u) ? 1u : 0u; mine = (j == x) ? c : mine; }
        if (sum == G) break;
        __builtin_amdgcn_s_sleep(1);
        if ((++sp & 255u) == 0u) { if (xb_ld(&bar[XB_TMO])) break; if (sp > XB_SPIN_CAP) { atomicAdd(&bar[XB_TMO], 1u); break; } }
    }
    nloc = mine > 0u ? mine : 1u; nx = cnt > 0u ? cnt : 1u;
}
__device__ __forceinline__ void xcd_barrier(const XcdBarrier& b) {
    asm volatile("s_waitcnt vmcnt(0)" ::: "memory");
    __syncthreads();
    if (threadIdx.x == 0) {
        unsigned* bar = b.bar;
        __builtin_amdgcn_s_waitcnt(0);
        unsigned nloc = b.st[0], nx = b.st[1];
        if (nloc == 0u) { xcd_barrier_complete(bar, b.x, nloc, nx); b.st[0] = nloc; b.st[1] = nx; }
        const unsigned old = xb_add(&bar[XB_XSUB(b.x)], 1u);
        const unsigned gen = old / nloc;
        if (old + 1u == (gen + 1u) * nloc) {
            __builtin_amdgcn_fence(__ATOMIC_RELEASE, "agent");
            asm volatile("s_waitcnt vmcnt(0)" ::: "memory");
            const unsigned og = xb_add(&bar[XB_TOP], 1u);
            const unsigned tg = og / nx;
            if (og + 1u == (tg + 1u) * nx) xb_add(&bar[XB_TOPGEN], 1u);
            else XB_SPIN(xb_ld(&bar[XB_TOPGEN]) == tg, bar);
            __builtin_amdgcn_fence(__ATOMIC_ACQUIRE, "agent");
            xb_add(&bar[XB_XGEN(b.x)], 1u);
            asm volatile("s_waitcnt vmcnt(0)" ::: "memory");
        } else {
            XB_SPIN(xb_ld(&bar[XB_XGEN(b.x)]) == gen, bar);
            __builtin_amdgcn_fence(__ATOMIC_ACQUIRE, "agent");
            asm volatile("s_waitcnt vmcnt(0)" ::: "memory");
        }
    }
    __syncthreads();
}

constexpr int NPHASE = 10;
constexpr int LDS_BYTES = 147456, L_MISC = LDS_BYTES - 64;
constexpr int CW_BAR = 1024;
constexpr size_t CTL_ZERO_BYTES = 32768;
__global__ void __launch_bounds__(512) fwd_kernel(Args a) {
    extern __shared__ __attribute__((aligned(16))) unsigned char lds_raw[];
    LAS unsigned char* lds = (LAS unsigned char*)lds_raw;
    const int tid = threadIdx.x, lane = tid & 63, wave = __builtin_amdgcn_readfirstlane(tid >> 6);
    unsigned char* ws = a.ws;
    const int lo = a.ph_lo, hi = a.ph_hi;
#ifndef PH_MASK
#define PH_MASK 0x3ff
#endif
#define IN(k) (((PH_MASK >> (k)) & 1) && lo <= (k) && (k) < hi)
#define SEAM(k) do { if (IN(k) && IN((k) + ((k) == 2 ? 2 : 1))) { xcd_barrier(bar); } } while (0)
    volatile LAS unsigned* misc = (volatile LAS unsigned*)(lds + L_MISC);
    if (tid < 16) misc[tid] = 0u;
    __syncthreads();
    XcdBarrier bar = xcd_barrier_post((unsigned*)(ws + WS_CTL) + CW_BAR, misc);
    if (lo < 0) cg::this_grid().sync();
    if (IN(0)) { p0_prologue(a, lds, tid, lane, wave); }
    SEAM(0);
    if (IN(1)) {
        if (blockIdx.x == 0) { const float* pb = (const float*)(ws + WS_PBIAS); float s = 0.f; const int kv = tid >> 8, n = tid & 255;
#pragma unroll
            for (int bb = 0; bb < 4; ++bb) { float part[32];
#pragma unroll
                for (int c = 0; c < 32; ++c) part[c] = pb[(size_t)(kv * 128 + bb * 32 + c) * 256 + n];
#pragma unroll
                for (int c = 0; c < 32; ++c) s += part[c]; }
            ((float*)(ws + WS_B1))[tid] = s; }
        SchedStd S; S.init(ws + WS_XB, DM, ws + WS_WIN, DM, T, IN_PAD, NREP(1));
        EpiProj E{(const float*)(ws + WS_RSTD0), (const float*)(ws + WS_ROPE), a.in[5], a.in[7], a.in[8], a.in[15], a.in[16],
                  (bf16_t*)(ws + WS_QN), (bf16_t*)(ws + WS_KC), (bf16_t*)(ws + WS_VC), (bf16_t*)(ws + WS_KS), (bf16_t*)(ws + WS_VS), (bf16_t*)(ws + WS_KW), (bf16_t*)(ws + WS_VW),
                  (bf16_t*)(ws + WS_QM), (bf16_t*)(ws + WS_KM), (bf16_t*)(ws + WS_VM), (bf16_t*)(ws + WS_GA), (bf16_t*)(ws + WS_GB), (float*)(ws + WS_GN)};
        pg8::gemm_phase(lds, DM, DM, DM, S, E);
    }
    SEAM(1);
    if (IN(2)) {
        kmean_phase(a, lane, wave);
        SchedStd S; S.init(ws + WS_PB, PLE, ws + WS_WPP, PLE, T, DM); EpiStoreBf16 E{(bf16_t*)(ws + WS_PP)}; pg8::gemm_phase(lds, PLE, PLE, PLE, S, E);
    }
    SEAM(2);
    if (IN(4)) { for (int rep = 0; rep < NREP(4); ++rep) attention_phase(a, lds, tid, lane, wave, rep); }
    SEAM(4);
    if (IN(5)) {
        SchedMerge S; S.init(ws + WS_YN, ws + WS_YM, ws + WS_WUPN, ws + WS_WUPM, 512, T, DM);
        EpiMerge E{(const bf16_t*)(ws + WS_GA), (const bf16_t*)(ws + WS_GB), (bf16_t*)(ws + WS_MB)};
        pg8::gemm_phase(lds, 512, 512, 512, S, E);
    }
    SEAM(5);
    if (IN(6)) {
        SchedStd S; S.init(ws + WS_MB, DM, ws + WS_WOUT, DM, T, DM);
        EpiResid<true> E{a.in[0], (bf16_t*)(ws + WS_XB), (float*)(ws + WS_RSSP)};
        pg8::gemm_phase(lds, DM, DM, DM, S, E);
    }
    SEAM(6);
    if (IN(7)) {
        SchedStd S; S.init(ws + WS_XB, DM, ws + WS_WFFI, DM, T, 2 * DFF, NREP(7));
        EpiFfnIn E{(const float*)(ws + WS_RSSP), (bf16_t*)(ws + WS_HB)};
        pg8::gemm_phase(lds, DM, DM, DM, S, E);
    }
    SEAM(7);
    if (IN(8)) {
        SchedStd S; S.init(ws + WS_HB, DFF, ws + WS_WFFO, DFF, T, DM);
        EpiResid<false> E{nullptr, (bf16_t*)(ws + WS_XB), (float*)(ws + WS_RSSP)};
        pg8::gemm_phase(lds, DFF, DFF, DFF, S, E);
    }
    SEAM(8);
    if (IN(9)) {
#ifndef NO_P9B
        { SchedStd S; S.init(ws + WS_XB, DM, ws + WS_WPG, DM, T, DM); EpiPle E{(const float*)(ws + WS_RSSP), (const bf16_t*)(ws + WS_PP), (const bf16_t*)(ws + WS_XB), a.out}; pg8::gemm_phase(lds, DM, DM, DM, S, E); }
#endif
    }
#undef IN
#undef SEAM
}

extern "C" void kernel_launch(void* const* d_in, const int* in_sizes, int n_in, void* d_out, int out_size, void* d_ws, size_t ws_size, hipStream_t stream) {
    static int grid = 0;
    if (grid == 0) {
        if (n_in != 26 || out_size != T * DM || ws_size < WS_END) { fprintf(stderr, "kernel_launch: unexpected shapes (n_in %d, out %d, ws %zu)\n", n_in, out_size, ws_size); grid = -1; return; }
        int dev = 0, cus = 0, per_cu = 0;
        hipGetDevice(&dev); hipDeviceGetAttribute(&cus, hipDeviceAttributeMultiprocessorCount, dev);
        if (hipFuncSetAttribute((const void*)fwd_kernel, hipFuncAttributeMaxDynamicSharedMemorySize, LDS_BYTES) != hipSuccess) { fprintf(stderr, "kernel_launch: hipFuncSetAttribute failed\n"); grid = -1; return; }
        if (hipOccupancyMaxActiveBlocksPerMultiprocessor(&per_cu, (const void*)fwd_kernel, 512, LDS_BYTES) != hipSuccess || per_cu < 1) { fprintf(stderr, "kernel_launch: occupancy query gave %d\n", per_cu); per_cu = 1; }
        (void)hipGetLastError();
        grid = cus * 1;
    }
    if (grid < 0) return;
    if (hipMemsetAsync((char*)d_ws + WS_CTL, 0, CTL_ZERO_BYTES, stream) != hipSuccess) { fprintf(stderr, "kernel_launch: memset failed\n"); return; }
    Args a{};
    for (int i = 0; i < 26; ++i) a.in[i] = (const float*)d_in[i];
    a.pos = (const int*)d_in[2]; a.out = (float*)d_out; a.ws = (unsigned char*)d_ws;
    for (int j = 0; j < 8; ++j) a.inv_freq[j] = powf(500000.0f, -(float)j / 8.0f);
#if MK_PER_PHASE
    for (int ph = 0; ph < NPHASE; ++ph) { a.ph_lo = ph; a.ph_hi = ph + 1; hipLaunchKernelGGL(fwd_kernel, dim3(grid), dim3(512), LDS_BYTES, stream, a); }
#else
    a.ph_lo = 0; a.ph_hi = NPHASE;
    void* args[] = {&a};
    hipError_t e = hipLaunchCooperativeKernel((const void*)fwd_kernel, dim3(grid), dim3(512), args, LDS_BYTES, stream);
    if (e != hipSuccess) fprintf(stderr, "cooperative launch failed: %s (grid %d)\n", hipGetErrorString(e), grid);
#endif
}
```
